# Optimizing an MI355X kernel written in HIP

```python
import jax, jax.numpy as jnp
from jax import lax
import numpy as np

D_MODEL = 1024
BATCH = 16
SEQ = 4096
DEPTH = 1

D_MIX = D_MODEL
A_HEADS = 8
A_DK = 64
A_DV = 64
A_KWIDTH = A_HEADS * A_DK
A_WIDTH = A_HEADS * A_DV
CHUNK = 64
B_HEADS = 4
B_NOPE = 128
B_ROPE = 64
B_V = 128
B_WIDTH = B_HEADS * B_V
Q_LORA = 384
KV_LORA = 256
ROPE_THETA = 10000.0
Q_BLOCK = 128
D_FF = ((8 * D_MODEL + 3 * 256 - 1) // (3 * 256)) * 256
EPS = 1e-6
IN_SPLITS = (A_KWIDTH, A_WIDTH, A_KWIDTH, A_KWIDTH, A_WIDTH, Q_LORA, KV_LORA, B_ROPE)
D_IN = A_KWIDTH * 3 + A_WIDTH * 2 + Q_LORA + KV_LORA + B_ROPE

kernel_name = 'hybrid_hgrn2_mla_encoder_block'


def _rmsnorm(x, g):
    xf = x.astype(jnp.float32)
    y = xf * lax.rsqrt(jnp.mean(xf * xf, axis=-1, keepdims=True) + EPS)
    return (y * g.astype(jnp.float32)).astype(x.dtype)


def _rope_tables(seq):
    inv = 1.0 / (ROPE_THETA ** (jnp.arange(0, B_ROPE, 2, dtype=jnp.float32) / B_ROPE))
    ang = jnp.arange(seq, dtype=jnp.float32)[:, None] * inv[None, :]
    return jnp.cos(ang), jnp.sin(ang)


def _apply_rope(x, cos, sin):
    xf = x.astype(jnp.float32)
    x1, x2 = jnp.split(xf, 2, axis=-1)
    out = jnp.concatenate([x1 * cos - x2 * sin, x1 * sin + x2 * cos], axis=-1)
    return out.astype(x.dtype)


def _gla_chunkwise(q, k, v, log_f):
    bsz, nh, seq, dk = q.shape
    dv = v.shape[-1]
    n = seq // CHUNK
    q = q.reshape(bsz, nh, n, CHUNK, dk)
    k = k.reshape(bsz, nh, n, CHUNK, dk)
    log_f = log_f.reshape(bsz, nh, n, CHUNK, dk)
    v = v.reshape(bsz, nh, n, CHUNK, dv)
    cum = jnp.cumsum(log_f, axis=3)
    last = cum[:, :, :, -1:, :]
    q_dec = q * jnp.exp(cum)
    k_inv = k * jnp.exp(-cum)
    k_to_end = k * jnp.exp(last - cum)
    mask = jnp.tril(jnp.ones((CHUNK, CHUNK), dtype=bool))
    scores = jnp.einsum('bhnid,bhnjd->bhnij', q_dec, k_inv)
    o_intra = jnp.einsum('bhnij,bhnje->bhnie', jnp.where(mask, scores, 0.0), v)
    u = jnp.einsum('bhnjd,bhnje->bhnde', k_to_end, v)
    decay = jnp.exp(last[:, :, :, 0, :])

    def step(s, xs):
        d, u_n = xs
        return d[..., None] * s + u_n, s

    s0 = jnp.zeros((bsz, nh, dk, dv), dtype=q.dtype)
    _, s_prev = lax.scan(step, s0, (jnp.moveaxis(decay, 2, 0), jnp.moveaxis(u, 2, 0)))
    s_prev = jnp.moveaxis(s_prev, 0, 2)
    o_inter = jnp.einsum('bhnid,bhnde->bhnie', q_dec, s_prev)
    return (o_intra + o_inter).reshape(bsz, nh, seq, dv)


def _hgrn2_group(hq, hi, hf_fwd, hf_bwd, hg, lb, norm_g):
    bsz, seq, _ = hq.shape
    f32 = jnp.float32

    def to_heads(a, d):
        return a.astype(f32).reshape(bsz, seq, A_HEADS, d).transpose(0, 2, 1, 3)

    q = to_heads(jax.nn.silu(hq), A_DK)
    v = to_heads(hi, A_DV)

    def direction(pre, lb_dir, reverse):
        lb_h = lb_dir.astype(f32).reshape(A_HEADS, 1, A_DK)
        z = to_heads(pre, A_DK)
        log_f = jnp.log(lb_h + (1.0 - lb_h) * jax.nn.sigmoid(z))
        k = (1.0 - lb_h) * jax.nn.sigmoid(-z)
        if reverse:
            o = _gla_chunkwise(jnp.flip(q, 2), jnp.flip(k, 2), jnp.flip(v, 2), jnp.flip(log_f, 2))
            return jnp.flip(o, 2)
        return _gla_chunkwise(q, k, v, log_f)

    o = direction(hf_fwd, lb[0], False) + direction(hf_bwd, lb[1], True)
    o = o.transpose(0, 2, 1, 3)
    o = o * lax.rsqrt(jnp.mean(o * o, axis=-1, keepdims=True) + EPS)
    o = o * norm_g.astype(f32).reshape(A_HEADS, A_DV)
    o = o.reshape(bsz, seq, A_WIDTH) * jax.nn.silu(hg.astype(f32))
    return o.astype(hq.dtype)


def _mla_group(c_q, c_kv, k_rope, g_qa, w_qb, g_kva, w_kvb, g_out):
    bsz, seq, _ = c_q.shape
    cos, sin = _rope_tables(seq)
    q = (_rmsnorm(c_q, g_qa) @ w_qb).reshape(bsz, seq, B_HEADS, B_NOPE + B_ROPE)
    q_nope, q_rope = q[..., :B_NOPE], q[..., B_NOPE:]
    kv = (_rmsnorm(c_kv, g_kva) @ w_kvb).reshape(bsz, seq, B_HEADS, B_NOPE + B_V)
    k_nope, v = kv[..., :B_NOPE], kv[..., B_NOPE:]
    q_rope = _apply_rope(q_rope, cos[:, None, :], sin[:, None, :])
    k_rope = _apply_rope(k_rope, cos, sin)
    scale = (B_NOPE + B_ROPE) ** -0.5
    n_blk = seq // Q_BLOCK
    qn_blocks = q_nope.reshape(bsz, n_blk, Q_BLOCK, B_HEADS, B_NOPE).swapaxes(0, 1)
    qr_blocks = q_rope.reshape(bsz, n_blk, Q_BLOCK, B_HEADS, B_ROPE).swapaxes(0, 1)

    def attend(blk):
        qn, qr = blk
        s = (jnp.einsum('bqhd,bkhd->bhqk', qn, k_nope)
             + jnp.einsum('bqhr,bkr->bhqk', qr, k_rope))
        p = jax.nn.softmax(s.astype(jnp.float32) * scale, axis=-1)
        return jnp.einsum('bhqk,bkhe->bqhe', p.astype(v.dtype), v)

    o = lax.map(attend, (qn_blocks, qr_blocks))
    o = o.swapaxes(0, 1).reshape(bsz, seq, B_WIDTH)
    return _rmsnorm(o, g_out)


def setup_inputs(seed: int = 0) -> dict:
    key = jax.random.key(seed)
    ks = jax.random.split(key, 20)
    f32 = jnp.float32

    def nrm(k, shape, fan_in):
        return jax.random.normal(k, shape, f32) * (fan_in ** -0.5)

    def gain(k, shape):
        return 1.0 + 0.02 * jax.random.normal(k, shape, f32)

    return {
        'x': jax.random.normal(ks[0], (BATCH, SEQ, D_MODEL), f32),
        'norm1_g': gain(ks[1], (DEPTH, D_MODEL)),
        'w_in': nrm(ks[2], (DEPTH, D_MODEL, D_IN), D_MODEL),
        'lb_logits': 0.1 * jax.random.normal(ks[3], (2, DEPTH + 1, A_KWIDTH), f32),
        'hgrn_norm_g': gain(ks[4], (DEPTH, A_WIDTH)),
        'q_a_norm_g': gain(ks[5], (DEPTH, Q_LORA)),
        'w_q_b': nrm(ks[6], (DEPTH, Q_LORA, B_HEADS * (B_NOPE + B_ROPE)), Q_LORA),
        'kv_a_norm_g': gain(ks[7], (DEPTH, KV_LORA)),
        'w_kv_b': nrm(ks[8], (DEPTH, KV_LORA, B_HEADS * (B_NOPE + B_V)), KV_LORA),
        'mla_norm_g': gain(ks[9], (DEPTH, B_WIDTH)),
        'w_out': nrm(ks[10], (DEPTH, D_MIX, D_MODEL), D_MIX),
        'norm2_g': gain(ks[11], (DEPTH, D_MODEL)),
        'w_gate': nrm(ks[12], (DEPTH, D_MODEL, D_FF), D_MODEL),
        'w_up': nrm(ks[13], (DEPTH, D_MODEL, D_FF), D_MODEL),
        'w_down': nrm(ks[14], (DEPTH, D_FF, D_MODEL), D_FF),
        'final_norm_g': gain(ks[15], (D_MODEL,)),
    }


def reference(x, norm1_g, w_in, lb_logits, hgrn_norm_g, q_a_norm_g, w_q_b, kv_a_norm_g,
              w_kv_b, mla_norm_g, w_out, norm2_g, w_gate, w_up, w_down, final_norm_g):
    p = jax.nn.softmax(lb_logits.astype(jnp.float32), axis=1)
    lower_bounds = jnp.cumsum(p, axis=1)[:, :DEPTH]
    split_at = [int(v) for v in np.cumsum(IN_SPLITS)[:-1]]
    for l in range(DEPTH):
        h = _rmsnorm(x, norm1_g[l])
        proj = h @ w_in[l]
        hq, hi, hf_fwd, hf_bwd, hg, c_q, c_kv, k_r = jnp.split(proj, split_at, axis=-1)
        y_a = _hgrn2_group(hq, hi, hf_fwd, hf_bwd, hg, lower_bounds[:, l], hgrn_norm_g[l])
        y_b = _mla_group(c_q, c_kv, k_r, q_a_norm_g[l], w_q_b[l], kv_a_norm_g[l],
                         w_kv_b[l], mla_norm_g[l])
        x = x + jnp.concatenate([y_a, y_b], axis=-1) @ w_out[l]
        h = _rmsnorm(x, norm2_g[l])
        x = x + (jax.nn.silu(h @ w_gate[l]) * (h @ w_up[l])) @ w_down[l]
    return _rmsnorm(x, final_norm_g)
```

```cpp
#include <hip/hip_runtime.h>
#include <hip/hip_cooperative_groups.h>
#include <cstdio>
#include <cstdint>
namespace cg = cooperative_groups;

typedef unsigned short bf16_t;
using bf16x8 = __attribute__((ext_vector_type(8))) short;
using s16x4  = __attribute__((ext_vector_type(4))) short;
using f32x4  = __attribute__((ext_vector_type(4))) float;
using f32x8  = __attribute__((ext_vector_type(8))) float;
using f32x16 = __attribute__((ext_vector_type(16))) float;
using u32x4  = __attribute__((ext_vector_type(4))) unsigned;
using u32x2  = __attribute__((ext_vector_type(2))) unsigned;
#define LAS __attribute__((address_space(3)))
#define DI __device__ __forceinline__

constexpr int MTOK = 65536, DM = 1024, SEQ = 4096, NBATCH = 16;
constexpr int DIN = 3264, DINP = 3328, DFF = 2816;
constexpr int QLORA = 384, KVLORA = 256, QW = 768, KVW = 1024;
constexpr float EPS = 1e-6f;
constexpr int C_HQ = 0, C_HI = 512, C_HF = 1024, C_HG = 2048, C_CQ = 2560, C_CKV = 2944, C_KR = 3200;

constexpr size_t WS_WIN  = 0;
constexpr size_t WS_WQB  = WS_WIN  + (size_t)DINP * DM * 2;
constexpr size_t WS_WKVB = WS_WQB  + (size_t)QW * QLORA * 2;
constexpr size_t WS_WOUT = WS_WKVB + (size_t)KVW * KVLORA * 2;
constexpr size_t WS_WGU  = WS_WOUT + (size_t)DM * DM * 2;
constexpr size_t WS_WDN  = WS_WGU  + (size_t)2 * DFF * DM * 2;
constexpr size_t WS_COS  = WS_WDN  + (size_t)DM * DFF * 2;
constexpr size_t WS_SIN  = WS_COS  + (size_t)SEQ * 32 * 4;
constexpr size_t WS_H    = WS_SIN  + (size_t)SEQ * 32 * 4;
constexpr size_t WS_PROJ = WS_H    + (size_t)MTOK * DM * 2;
constexpr size_t WS_HID  = WS_PROJ;
constexpr size_t WS_R2   = WS_PROJ + (size_t)MTOK * DINP * 2;
constexpr size_t WS_CQN  = WS_R2;
constexpr size_t WS_CKVN = WS_CQN  + (size_t)MTOK * QLORA * 2;
constexpr size_t WS_KR   = WS_CKVN + (size_t)MTOK * KVLORA * 2;
constexpr size_t WS_QB   = WS_KR   + (size_t)MTOK * 64 * 2;
constexpr size_t WS_KV   = WS_QB   + (size_t)MTOK * QW * 2;
constexpr size_t WS_END  = WS_KV   + (size_t)MTOK * KVW * 2;
constexpr size_t WS_OA   = WS_CQN;
constexpr size_t WS_X1   = WS_R2;
constexpr size_t WS_X2   = WS_H;
constexpr size_t WS_SSQ1 = WS_END + 16384;
constexpr size_t WS_SSQ2 = WS_SSQ1 + (size_t)MTOK * 4;
constexpr size_t WS_SSQQ = WS_SSQ2 + (size_t)MTOK * 4;
constexpr size_t WS_SSQKV = WS_SSQQ + (size_t)MTOK * 4;
constexpr size_t WS_OML = WS_SSQKV + (size_t)MTOK * 4;
constexpr size_t WS_XST = WS_OML + 2 * 512 * 4;
constexpr size_t WS_SSQ0 = WS_XST + (size_t)MTOK * 4 * 4;
constexpr size_t WS_TOTAL = WS_SSQ0 + (size_t)MTOK * 4;
static_assert(WS_TOTAL <= (size_t)1 << 30, "workspace total");
static_assert((size_t)MTOK * 512 * 2 <= (size_t)MTOK * (QLORA + KVLORA) * 2, "OA overlay");
static_assert((size_t)MTOK * DM * 4 <= WS_END - WS_R2, "X1 overlay");
static_assert(WS_END <= (size_t)1 << 30, "workspace");

struct Params {
    const float* x; const float* norm1_g; const float* w_in; const float* lb_logits; const float* hgrn_norm_g;
    const float* q_a_norm_g; const float* w_q_b; const float* kv_a_norm_g; const float* w_kv_b; const float* mla_norm_g;
    const float* w_out; const float* norm2_g; const float* w_gate; const float* w_up; const float* w_down; const float* final_norm_g;
    float* out; unsigned char* ws;
};

DI float bf2f(short u) { return __uint_as_float(((unsigned)(unsigned short)u) << 16); }
typedef __bf16 bf16x2_t __attribute__((ext_vector_type(2)));
typedef float f32x2_t __attribute__((ext_vector_type(2)));
DI unsigned cvtpk(float lo, float hi) { f32x2_t v = {lo, hi}; bf16x2_t b = __builtin_convertvector(v, bf16x2_t); return __builtin_bit_cast(unsigned, b); }
DI bf16x8 pack8(const float* v) { u32x4 w = {cvtpk(v[0], v[1]), cvtpk(v[2], v[3]), cvtpk(v[4], v[5]), cvtpk(v[6], v[7])}; return __builtin_bit_cast(bf16x8, w); }
DI float wave_sum(float v) {
#pragma unroll
    for (int o = 32; o > 0; o >>= 1) v += __shfl_xor(v, o);
    return v;
}
DI int opaque_tid() { int t = threadIdx.x; asm volatile("" : "+v"(t)); return t; }
DI int fresh_gw() { return (int)blockIdx.x * 8 + (opaque_tid() >> 6); }
DI int perm32(int rho) { const int n = rho >> 4, i = rho & 15; return 8 * (i >> 2) + 4 * n + (i & 3); }

constexpr int BM = 256, BK = 64, HALF = 128, HT = HALF * BK, GEMM_LDS = 8 * HT * 2, NXCD = 8, WGM = 8;
DI int lds_byte(int r, int c) { int st = (r >> 4) * 2 + (c >> 5), rr = r & 15, cc = c & 31, ob = rr * 64 + cc * 2; return st * 1024 + (ob ^ (((ob >> 9) & 1) << 5)); }
DI void stage_rc(int b, int& R, int& C) { int st = b / 1024, sb = b % 1024, swz = sb ^ (((sb >> 9) & 1) << 5); R = (st >> 1) * 16 + swz / 64; C = (st & 1) * 32 + (swz % 64) / 2; }

template <class Epi>
DI void gemm_unit(const bf16_t* __restrict__ A, long lda, const bf16_t* __restrict__ Bt, int K, int pm, int pn, const Epi& epi, LAS char* shmc) {
    LAS bf16_t* shm = (LAS bf16_t*)shmc;
    const int tidx = opaque_tid();
#define SA(b, h) (shm + ((b) * 2 + (h)) * HT)
#define SB(b, h) (shm + (4 + (b) * 2 + (h)) * HT)
#define STAGE(P, BASE, LD, br, kt, OFF) do { const char* _ub = (const char*)((BASE) + (long)(br) * (LD) + (long)(kt) * BK); \
    _Pragma("unroll") for (int _i = 0; _i < 2; ++_i) { \
      __builtin_amdgcn_global_load_lds((const unsigned*)(_ub + OFF[_i]), (LAS unsigned*)((LAS char*)(P) + tidx * 16 + _i * 8192), 16, 0, 0); } } while (0)
#define LDA(dst, b, h) _Pragma("unroll") for (int m = 0; m < 4; ++m) _Pragma("unroll") for (int k = 0; k < 2; ++k) \
    dst[m][k] = *reinterpret_cast<const LAS bf16x8*>((LAS char*)SA(b, h) + lds_byte(wr * 64 + m * 16 + fr, k * 32 + fq * 8))
#define LDB(dst, b, h) _Pragma("unroll") for (int n = 0; n < 2; ++n) _Pragma("unroll") for (int k = 0; k < 2; ++k) \
    dst[n][k] = *reinterpret_cast<const LAS bf16x8*>((LAS char*)SB(b, h) + lds_byte(wc * 32 + n * 16 + fr, k * 32 + fq * 8))
#define MMA(ai, bj, At, Bt_) do { __builtin_amdgcn_s_setprio(1); \
    _Pragma("unroll") for (int m = 0; m < 4; ++m) _Pragma("unroll") for (int n = 0; n < 2; ++n) _Pragma("unroll") for (int k = 0; k < 2; ++k) \
      acc[ai][bj][m][n] = __builtin_amdgcn_mfma_f32_16x16x32_bf16(Bt_[n][k], At[m][k], acc[ai][bj][m][n], 0, 0, 0); \
    __builtin_amdgcn_s_setprio(0); } while (0)
#define WAIT_V(n) asm volatile("s_waitcnt vmcnt(" #n ")" ::: "memory")
#define WAIT_L(n) asm volatile("s_waitcnt lgkmcnt(" #n ")" ::: "memory")
#define BAR __builtin_amdgcn_s_barrier()
#define SCHED __builtin_amdgcn_sched_barrier(0)
    const int brow = pm * BM, bcol = pn * BM;
    const int wid = tidx >> 6, lane = tidx & 63, wr = wid >> 2, wc = wid & 3, fr = lane & 15, fq = lane >> 4;
    f32x4 acc[2][2][4][2] = {};
    bf16x8 At[4][2], B0[2][2], B1[2][2];
    const int nt = K / BK;
    unsigned offA[2], offB[2];
#pragma unroll
    for (int _i = 0; _i < 2; ++_i) { int _r, _c; stage_rc(tidx * 16 + _i * 8192, _r, _c); offA[_i] = (unsigned)(_r * (int)lda + _c) * 2u; offB[_i] = (unsigned)(_r * K + _c) * 2u; }
    STAGE(SB(0, 0), Bt, K, bcol, 0, offB); STAGE(SA(0, 0), A, lda, brow, 0, offA);
    STAGE(SB(0, 1), Bt, K, bcol + HALF, 0, offB); STAGE(SA(0, 1), A, lda, brow + HALF, 0, offA);
    if (wr == 1) BAR;
    WAIT_V(4); BAR;
    STAGE(SB(1, 0), Bt, K, bcol, 1, offB); STAGE(SA(1, 0), A, lda, brow, 1, offA); STAGE(SB(1, 1), Bt, K, bcol + HALF, 1, offB);
    WAIT_V(6); BAR;
#pragma unroll 1
    for (int t = 0; t < nt - 2; t += 2) {
        LDB(B0, 0, 0); SCHED; LDA(At, 0, 0); STAGE(SA(1, 1), A, lda, brow + HALF, t + 1, offA);
        WAIT_L(8); BAR; WAIT_L(0); MMA(0, 0, At, B0); BAR; SCHED;
        LDB(B1, 0, 1); STAGE(SB(0, 0), Bt, K, bcol, t + 2, offB);
        BAR; WAIT_L(0); MMA(0, 1, At, B1); BAR;
        LDA(At, 0, 1); STAGE(SA(0, 0), A, lda, brow, t + 2, offA);
        BAR; WAIT_L(0); MMA(1, 0, At, B0); BAR; SCHED;
        STAGE(SB(0, 1), Bt, K, bcol + HALF, t + 2, offB);
        WAIT_V(6); BAR; MMA(1, 1, At, B1); BAR;
        LDB(B0, 1, 0); SCHED; LDA(At, 1, 0); STAGE(SA(0, 1), A, lda, brow + HALF, t + 2, offA);
        WAIT_L(8); BAR; WAIT_L(0); MMA(0, 0, At, B0); BAR; SCHED;
        LDB(B1, 1, 1); STAGE(SB(1, 0), Bt, K, bcol, t + 3, offB);
        BAR; WAIT_L(0); MMA(0, 1, At, B1); BAR;
        LDA(At, 1, 1); STAGE(SA(1, 0), A, lda, brow, t + 3, offA);
        BAR; WAIT_L(0); MMA(1, 0, At, B0); BAR; SCHED;
        STAGE(SB(1, 1), Bt, K, bcol + HALF, t + 3, offB);
        WAIT_V(6); BAR; MMA(1, 1, At, B1); BAR;
    }
    { LDB(B0, 0, 0); LDA(At, 0, 0); STAGE(SA(1, 1), A, lda, brow + HALF, nt - 1, offA);
      BAR; WAIT_L(0); MMA(0, 0, At, B0); BAR;
      LDB(B1, 0, 1); BAR; WAIT_L(0); MMA(0, 1, At, B1); BAR;
      LDA(At, 0, 1); WAIT_V(4); BAR; WAIT_L(0); MMA(1, 0, At, B0); MMA(1, 1, At, B1); BAR; }
    { LDB(B0, 1, 0); LDA(At, 1, 0); WAIT_V(2); BAR; WAIT_L(0); MMA(0, 0, At, B0); BAR;
      LDB(B1, 1, 1); WAIT_V(0); BAR; WAIT_L(0); MMA(0, 1, At, B1); BAR;
      LDA(At, 1, 1); BAR; WAIT_L(0); MMA(1, 0, At, B0); MMA(1, 1, At, B1); BAR; }
    if (wr == 0) BAR;
    epi(acc, pm, pn, wr, wc, fr, fq);
#undef SA
#undef SB
#undef STAGE
#undef LDA
#undef LDB
#undef MMA
}

DI bool unit_order(int L, int nM, int nN, int& pm, int& pn) {
    const int nwg = nM * nN; if (L >= nwg) return false;
    int wgid = L; { const int q = nwg / NXCD, r = nwg % NXCD, xcd = wgid % NXCD, off = wgid / NXCD; wgid = (xcd < r ? xcd * (q + 1) : r * (q + 1) + (xcd - r) * q) + off; }
    const int nig = WGM * nN, gid = wgid / nig, fm = gid * WGM, gsz = (nM - fm) < WGM ? (nM - fm) : WGM;
    pm = fm + ((wgid % nig) % gsz); pn = (wgid % nig) / gsz; return true;
}
template <class Epi>
DI void gemm_phase(const bf16_t* A, long lda, const bf16_t* Bt, int K, int nM, int nN, const Epi& epi, LAS char* lds) {
    for (int i = 0;; ++i) { int pm, pn; if (!unit_order(i * (int)gridDim.x + (int)blockIdx.x, nM, nN, pm, pn)) break; gemm_unit(A, lda, Bt, K, pm, pn, epi, lds); }
}

template <bool NT>
struct EpiBf16 {
    bf16_t* O; long ldc;
    DI void operator()(const f32x4 (&acc)[2][2][4][2], int pm, int pn, int wr, int wc, int fr, int fq) const {
#pragma unroll
        for (int ai = 0; ai < 2; ++ai)
#pragma unroll
            for (int m = 0; m < 4; ++m) { bf16_t* rowp = O + (long)(pm * BM + ai * HALF + wr * 64 + m * 16 + fr) * ldc + pn * BM + wc * 32 + 8 * fq;
#pragma unroll
                for (int bj = 0; bj < 2; ++bj) { const f32x4 v0 = acc[ai][bj][m][0], v1 = acc[ai][bj][m][1];
                    u32x4 w = {cvtpk(v0[0], v0[1]), cvtpk(v0[2], v0[3]), cvtpk(v1[0], v1[1]), cvtpk(v1[2], v1[3])};
                    if (NT) __builtin_nontemporal_store(w, (u32x4*)(rowp + bj * HALF)); else *(u32x4*)(rowp + bj * HALF) = w; } }
    }
};
struct EpiProj {
    bf16_t* O; float* ssq_q; float* ssq_kv; const float* oml; const float* ssq0;
    DI void operator()(const f32x4 (&acc)[2][2][4][2], int pm, int pn, int wr, int wc, int fr, int fq) const {
#pragma unroll
        for (int ai = 0; ai < 2; ++ai)
#pragma unroll
            for (int m = 0; m < 4; ++m) { const int row = pm * BM + ai * HALF + wr * 64 + m * 16 + fr; bf16_t* rowp = O + (long)row * DINP + pn * BM + wc * 32 + 8 * fq;
                float s[2];
                const float rs1 = rsqrtf(ssq0[row] * (1.f / DM) + EPS);
#pragma unroll
                for (int bj = 0; bj < 2; ++bj) { f32x4 v0 = acc[ai][bj][m][0] * rs1, v1 = acc[ai][bj][m][1] * rs1;
                    s[bj] = v0[0] * v0[0] + v0[1] * v0[1] + v0[2] * v0[2] + v0[3] * v0[3] + v1[0] * v1[0] + v1[1] * v1[1] + v1[2] * v1[2] + v1[3] * v1[3];
                    const int cat = (2 * pn + bj) >> 2;
                    if (cat == 0 || cat == 4) {
#pragma unroll
                        for (int j = 0; j < 4; ++j) { v0[j] = v0[j] * __builtin_amdgcn_rcpf(1.f + __expf(-v0[j])); v1[j] = v1[j] * __builtin_amdgcn_rcpf(1.f + __expf(-v1[j])); }
                    } else if (cat == 2 || cat == 3) {
                        const float* op = oml + (cat - 2) * 512 + (pn * BM + bj * HALF - cat * 512) + wc * 32 + 8 * fq;
                        const f32x4 m0 = *(const f32x4*)op, m1 = *(const f32x4*)(op + 4);
#pragma unroll
                        for (int j = 0; j < 4; ++j) { v0[j] = m0[j] * __builtin_amdgcn_rcpf(1.f + __expf(fminf(v0[j], 80.f))); v1[j] = m1[j] * __builtin_amdgcn_rcpf(1.f + __expf(fminf(v1[j], 80.f))); }
                    }
                    u32x4 w = {cvtpk(v0[0], v0[1]), cvtpk(v0[2], v0[3]), cvtpk(v1[0], v1[1]), cvtpk(v1[2], v1[3])};
                    __builtin_nontemporal_store(w, (u32x4*)(rowp + bj * HALF)); }
                if (pn >= 10) {
                    float sq = pn == 10 ? s[0] + s[1] : (pn == 11 ? s[0] : 0.f), sk = pn == 11 ? s[1] : (pn == 12 ? s[0] : 0.f);
                    sq += __shfl_xor(sq, 16); sq += __shfl_xor(sq, 32); sk += __shfl_xor(sk, 16); sk += __shfl_xor(sk, 32);
                    if (fq == 0) { if (pn <= 11) atomicAdd(ssq_q + row, sq); if (pn >= 11) atomicAdd(ssq_kv + row, sk); } } }
    }
};
struct EpiBf16Scale {
    bf16_t* O; long ldc; const float* ssq; float inv_k;
    DI void operator()(const f32x4 (&acc)[2][2][4][2], int pm, int pn, int wr, int wc, int fr, int fq) const {
#pragma unroll
        for (int ai = 0; ai < 2; ++ai)
#pragma unroll
            for (int m = 0; m < 4; ++m) { const int row = pm * BM + ai * HALF + wr * 64 + m * 16 + fr; bf16_t* rowp = O + (long)row * ldc + pn * BM + wc * 32 + 8 * fq;
                const float rs = rsqrtf(ssq[row] * inv_k + EPS);
#pragma unroll
                for (int bj = 0; bj < 2; ++bj) { const f32x4 v0 = acc[ai][bj][m][0] * rs, v1 = acc[ai][bj][m][1] * rs;
                    u32x4 w = {cvtpk(v0[0], v0[1]), cvtpk(v0[2], v0[3]), cvtpk(v1[0], v1[1]), cvtpk(v1[2], v1[3])};
                    *(u32x4*)(rowp + bj * HALF) = w; }
                asm volatile("" ::: "memory"); }
    }
};
template <bool R_F32>
struct EpiResid {
    const void* R; bf16_t* O; float* ssq;
    DI void operator()(const f32x4 (&acc)[2][2][4][2], int pm, int pn, int wr, int wc, int fr, int fq) const {
#pragma unroll
        for (int ai = 0; ai < 2; ++ai)
#pragma unroll
            for (int m = 0; m < 4; ++m) { const int row = pm * BM + ai * HALF + wr * 64 + m * 16 + fr; const long off = (long)row * DM + pn * BM + wc * 32 + 8 * fq;
                float s = 0.f;
#pragma unroll
                for (int bj = 0; bj < 2; ++bj) {
                    float v[8];
                    if (R_F32) { const f32x4 r0 = *(const f32x4*)((const float*)R + off + bj * HALF), r1 = *(const f32x4*)((const float*)R + off + bj * HALF + 4);
#pragma unroll
                        for (int j = 0; j < 4; ++j) { v[j] = r0[j] + acc[ai][bj][m][0][j]; v[4 + j] = r1[j] + acc[ai][bj][m][1][j]; }
                    } else { const bf16x8 r = *(const bf16x8*)((const bf16_t*)R + off + bj * HALF);
#pragma unroll
                        for (int j = 0; j < 4; ++j) { v[j] = bf2f(r[j]) + acc[ai][bj][m][0][j]; v[4 + j] = bf2f(r[4 + j]) + acc[ai][bj][m][1][j]; } }
#pragma unroll
                    for (int j = 0; j < 8; ++j) s += v[j] * v[j];
                    *(bf16x8*)(O + off + bj * HALF) = pack8(v); }
                s += __shfl_xor(s, 16); s += __shfl_xor(s, 32);
                if (fq == 0) atomicAdd(ssq + row, s); }
    }
};
struct EpiFinal {
    const bf16_t* R; float* out; float* xst; const float* g; LAS char* lds;
    DI void operator()(const f32x4 (&acc)[2][2][4][2], int pm, int pn, int wr, int wc, int fr, int fq) const {
        LAS float* rowss = (LAS float*)(lds + GEMM_LDS + 256); LAS float* rsl = rowss + 256;
#pragma unroll
        for (int ai = 0; ai < 2; ++ai)
#pragma unroll
            for (int m = 0; m < 4; ++m) { const int rl = ai * HALF + wr * 64 + m * 16 + fr; const long off = (long)(pm * BM + rl) * DM + pn * BM + wc * 32 + 8 * fq;
                float s = 0.f;
#pragma unroll
                for (int bj = 0; bj < 2; ++bj) { const bf16x8 r = *(const bf16x8*)(R + off + bj * HALF);
#pragma unroll
                    for (int j = 0; j < 4; ++j) { const float a = bf2f(r[j]) + acc[ai][bj][m][0][j], b = bf2f(r[4 + j]) + acc[ai][bj][m][1][j]; s += a * a + b * b; } }
                s += __shfl_xor(s, 16); s += __shfl_xor(s, 32);
                if (fq == 0) (void)__hip_atomic_fetch_add(rowss + rl, s, __ATOMIC_RELAXED, __HIP_MEMORY_SCOPE_WORKGROUP); }
        __syncthreads();
        const int tid = opaque_tid();
        if (tid < 256) { const float mine = rowss[tid]; rowss[tid] = 0.f;
            float* slot = xst + (long)(pm * BM + tid) * 4;
            __hip_atomic_store(slot + pn, mine, __ATOMIC_RELAXED, __HIP_MEMORY_SCOPE_AGENT);
            float tot = 0.f;
#pragma unroll
            for (int q = 0; q < 4; ++q) { float v = mine;
                if (q != pn) { unsigned sp = 0; v = __hip_atomic_load(slot + q, __ATOMIC_RELAXED, __HIP_MEMORY_SCOPE_AGENT);
                    while (v < 0.f && ++sp < (1u << 22)) { __builtin_amdgcn_s_sleep(1); v = __hip_atomic_load(slot + q, __ATOMIC_RELAXED, __HIP_MEMORY_SCOPE_AGENT); } }
                tot += v; }
            rsl[tid] = rsqrtf(tot * (1.f / DM) + EPS); }
        __syncthreads();
        const float* gp = g + pn * BM + wc * 32 + 8 * fq;
        f32x4 gv[2][2];
#pragma unroll
        for (int bj = 0; bj < 2; ++bj) { gv[bj][0] = *(const f32x4*)(gp + bj * HALF); gv[bj][1] = *(const f32x4*)(gp + bj * HALF + 4); }
#pragma unroll
        for (int ai = 0; ai < 2; ++ai)
#pragma unroll
            for (int m = 0; m < 4; ++m) { const int rl = ai * HALF + wr * 64 + m * 16 + fr; const long off = (long)(pm * BM + rl) * DM + pn * BM + wc * 32 + 8 * fq;
                const float rs = rsl[rl];
#pragma unroll
                for (int bj = 0; bj < 2; ++bj) { const bf16x8 r = *(const bf16x8*)(R + off + bj * HALF);
                    f32x4 a, b;
#pragma unroll
                    for (int j = 0; j < 4; ++j) { a[j] = (bf2f(r[j]) + acc[ai][bj][m][0][j]) * rs * gv[bj][0][j]; b[j] = (bf2f(r[4 + j]) + acc[ai][bj][m][1][j]) * rs * gv[bj][1][j]; }
                    __builtin_nontemporal_store(a, (f32x4*)(out + off + bj * HALF)); __builtin_nontemporal_store(b, (f32x4*)(out + off + bj * HALF + 4)); } }
    }
};
struct EpiSwiGLU {
    bf16_t* O; const float* ssq;
    DI void operator()(const f32x4 (&acc)[2][2][4][2], int pm, int pn, int wr, int wc, int fr, int fq) const {
#pragma unroll
        for (int ai = 0; ai < 2; ++ai)
#pragma unroll
            for (int m = 0; m < 4; ++m) { const int row = pm * BM + ai * HALF + wr * 64 + m * 16 + fr; bf16_t* rowp = O + (long)row * DFF + pn * HALF + wc * 32 + 8 * fq;
                const float rs = rsqrtf(ssq[row] * (1.f / DM) + EPS);
                float h[8];
#pragma unroll
                for (int n = 0; n < 2; ++n)
#pragma unroll
                    for (int j = 0; j < 4; ++j) { const float g = acc[ai][0][m][n][j] * rs, u = acc[ai][1][m][n][j] * rs; h[n * 4 + j] = g * __builtin_amdgcn_rcpf(1.f + __expf(-g)) * u; }
                __builtin_nontemporal_store(pack8(h), (bf16x8*)rowp); }
    }
};

template <class Src, class RowMap>
DI void wt_convert(bf16_t* Wt, int K, int Npad, const Src& src, const RowMap& rowmap, int gw, int nw) {
    const int lane = opaque_tid() & 63, nl = lane & 15, kq = lane >> 4;
    const int nblocks = Npad / 16, items = nblocks * (K / 32);
    for (int it = gw; it < items; it += nw) {
        const int nb = it % nblocks, kb = it / nblocks, n = nb * 16 + nl, k0 = kb * 32 + kq * 8;
        float v[8];
#pragma unroll
        for (int i = 0; i < 8; ++i) v[i] = src(k0 + i, n);
        *(bf16x8*)(Wt + (long)rowmap(n) * K + k0) = pack8(v);
    }
}
template <bool OUT_F32>
DI void rmsnorm_rows(const float* X, const float* g, void* Out, int gw, int nw) {
    constexpr int RB = 4;
    const int lane = opaque_tid() & 63;
    f32x4 gv[4];
#pragma unroll
    for (int i = 0; i < 2; ++i) { gv[2 * i] = *(const f32x4*)(g + lane * 8 + 512 * i); gv[2 * i + 1] = *(const f32x4*)(g + lane * 8 + 512 * i + 4); }
    for (int row0 = gw * RB; row0 < MTOK; row0 += nw * RB) {
        f32x4 v[RB][4];
#pragma unroll
        for (int r = 0; r < RB; ++r) { const float* xr = X + (long)(row0 + r) * DM;
#pragma unroll
            for (int i = 0; i < 2; ++i) { v[r][2 * i] = __builtin_nontemporal_load((const f32x4*)(xr + lane * 8 + 512 * i)); v[r][2 * i + 1] = __builtin_nontemporal_load((const f32x4*)(xr + lane * 8 + 512 * i + 4)); } }
#pragma unroll
        for (int r = 0; r < RB; ++r) {
            float ss = 0.f;
#pragma unroll
            for (int i = 0; i < 4; ++i) ss += v[r][i][0] * v[r][i][0] + v[r][i][1] * v[r][i][1] + v[r][i][2] * v[r][i][2] + v[r][i][3] * v[r][i][3];
            ss = wave_sum(ss);
            const float rs = rsqrtf(ss * (1.f / DM) + EPS);
#pragma unroll
            for (int i = 0; i < 4; ++i) v[r][i] = v[r][i] * rs * gv[i];
            if (OUT_F32) { float* o = (float*)Out + (long)(row0 + r) * DM;
#pragma unroll
                for (int i = 0; i < 2; ++i) { *(f32x4*)(o + lane * 8 + 512 * i) = v[r][2 * i]; *(f32x4*)(o + lane * 8 + 512 * i + 4) = v[r][2 * i + 1]; }
            } else { bf16_t* o = (bf16_t*)Out + (long)(row0 + r) * DM;
#pragma unroll
                for (int i = 0; i < 2; ++i) { u32x4 w = {cvtpk(v[r][2 * i][0], v[r][2 * i][1]), cvtpk(v[r][2 * i][2], v[r][2 * i][3]), cvtpk(v[r][2 * i + 1][0], v[r][2 * i + 1][1]), cvtpk(v[r][2 * i + 1][2], v[r][2 * i + 1][3])};
                    *(u32x4*)(o + lane * 8 + 512 * i) = w; }
            }
        }
    }
}

DI void xcast_rows(const float* X, bf16_t* Out, float* ssq, int gw, int nw) {
    constexpr int RB = 4;
    const int lane = opaque_tid() & 63;
    for (int row0 = gw * RB; row0 < MTOK; row0 += nw * RB) {
        f32x4 v[RB][4];
#pragma unroll
        for (int r = 0; r < RB; ++r) { const float* xr = X + (long)(row0 + r) * DM;
#pragma unroll
            for (int i = 0; i < 2; ++i) { v[r][2 * i] = __builtin_nontemporal_load((const f32x4*)(xr + lane * 8 + 512 * i)); v[r][2 * i + 1] = __builtin_nontemporal_load((const f32x4*)(xr + lane * 8 + 512 * i + 4)); } }
#pragma unroll
        for (int r = 0; r < RB; ++r) {
            float ss = 0.f;
#pragma unroll
            for (int i = 0; i < 4; ++i) ss += v[r][i][0] * v[r][i][0] + v[r][i][1] * v[r][i][1] + v[r][i][2] * v[r][i][2] + v[r][i][3] * v[r][i][3];
            ss = wave_sum(ss);
            if (lane == 0) ssq[row0 + r] = ss;
            bf16_t* o = Out + (long)(row0 + r) * DM;
#pragma unroll
            for (int i = 0; i < 2; ++i) { u32x4 w = {cvtpk(v[r][2 * i][0], v[r][2 * i][1]), cvtpk(v[r][2 * i][2], v[r][2 * i][3]), cvtpk(v[r][2 * i + 1][0], v[r][2 * i + 1][1]), cvtpk(v[r][2 * i + 1][2], v[r][2 * i + 1][3])};
                *(u32x4*)(o + lane * 8 + 512 * i) = w; }
        }
    }
}
DI void phase0(const Params& p, int gw0, int nw0) {
    unsigned char* ws = p.ws;
    const int wib = gw0 & 7, gw = (gw0 >> 3) * 4 + (wib & 3), nw = nw0 >> 1;
    if (wib < 4) { xcast_rows(p.x, (bf16_t*)(ws + WS_H), (float*)(ws + WS_SSQ0), gw, nw); return; }
    { const float* W = p.w_in; const float* g1 = p.norm1_g; wt_convert((bf16_t*)(ws + WS_WIN), DM, DINP, [=](int k, int n) { const int c = (n & ~31) + perm32(n & 31); return c < DIN ? W[(long)k * DIN + c] * g1[k] : 0.f; }, [](int n) { return n; }, gw, nw); }
    { const float* W = p.w_q_b; const float* gq = p.q_a_norm_g; wt_convert((bf16_t*)(ws + WS_WQB), QLORA, QW, [=](int k, int n) { const int c = (n & ~31) + perm32(n & 31); return W[(long)k * QW + c] * gq[k]; }, [](int n) { return n; }, gw, nw); }
    { const float* W = p.w_kv_b; const float* gk = p.kv_a_norm_g; wt_convert((bf16_t*)(ws + WS_WKVB), KVLORA, KVW, [=](int k, int n) { const int c = (n & ~31) + perm32(n & 31); return W[(long)k * KVW + c] * gk[k]; }, [](int n) { return n; }, gw, nw); }
    { const float* W = p.w_out; wt_convert((bf16_t*)(ws + WS_WOUT), DM, DM, [=](int k, int n) { const int c = (n & ~31) + perm32(n & 31); return W[(long)k * DM + c]; }, [](int n) { return n; }, gw, nw); }
    { const float* W = p.w_gate; const float* g2 = p.norm2_g; wt_convert((bf16_t*)(ws + WS_WGU), DM, DFF, [=](int k, int n) { const int c = (n & ~31) + perm32(n & 31); return W[(long)k * DFF + c] * g2[k]; },
                                            [](int n) { return (n >> 7) * 256 + (n & 127); }, gw, nw); }
    { const float* W = p.w_up; const float* g2 = p.norm2_g; wt_convert((bf16_t*)(ws + WS_WGU), DM, DFF, [=](int k, int n) { const int c = (n & ~31) + perm32(n & 31); return W[(long)k * DFF + c] * g2[k]; },
                                          [](int n) { return (n >> 7) * 256 + 128 + (n & 127); }, gw, nw); }
    { const float* W = p.w_down; wt_convert((bf16_t*)(ws + WS_WDN), DFF, DM, [=](int k, int n) { const int c = (n & ~31) + perm32(n & 31); return W[(long)k * DM + c]; }, [](int n) { return n; }, gw, nw); }
    { float* cs = (float*)(ws + WS_COS); float* sn = (float*)(ws + WS_SIN); const int lane = opaque_tid() & 63;
      for (int idx = gw * 64 + lane; idx < SEQ * 32; idx += nw * 64) { const int pos = idx >> 5, i = idx & 31;
          const float inv = 1.0f / powf(10000.0f, (float)(2 * i) / 64.0f); const float ang = (float)pos * inv; float s, c; sincosf(ang, &s, &c); cs[idx] = c; sn[idx] = s; } }
    { float* om = (float*)(ws + WS_OML); const int lane = opaque_tid() & 63; const int idx = gw * 64 + lane;
      if (idx < 1024) { const int dir = idx >> 9, c = idx & 511; const float a0 = p.lb_logits[dir * 1024 + c], a1 = p.lb_logits[dir * 1024 + 512 + c]; om[idx] = 1.f - 1.f / (1.f + expf(a1 - a0)); } }
    { float* xs = (float*)(ws + WS_XST); const int lane = opaque_tid() & 63; for (int idx = gw * 64 + lane; idx < 4 * MTOK; idx += nw * 64) xs[idx] = -1.f; }
    { float* z = (float*)(ws + WS_SSQ1); const int lane = opaque_tid() & 63; for (int idx = gw * 64 + lane; idx < 4 * MTOK; idx += nw * 64) z[idx] = 0.f; }
}
DI void phase_final(const Params& p, int gw, int nw) {
    constexpr int RB = 4;
    const int lane = opaque_tid() & 63;
    const bf16_t* X2 = (const bf16_t*)(p.ws + WS_X2); const float* ssq = (const float*)(p.ws + WS_SSQ2);
    f32x4 gv[4];
#pragma unroll
    for (int i = 0; i < 2; ++i) { gv[2 * i] = *(const f32x4*)(p.final_norm_g + lane * 8 + 512 * i); gv[2 * i + 1] = *(const f32x4*)(p.final_norm_g + lane * 8 + 512 * i + 4); }
    for (int row0 = gw * RB; row0 < MTOK; row0 += nw * RB) {
        bf16x8 v[RB][2]; float rs[RB];
#pragma unroll
        for (int r = 0; r < RB; ++r) { const bf16_t* xr = X2 + (long)(row0 + r) * DM; v[r][0] = *(const bf16x8*)(xr + lane * 8); v[r][1] = *(const bf16x8*)(xr + lane * 8 + 512); rs[r] = rsqrtf(ssq[row0 + r] * (1.f / DM) + EPS); }
#pragma unroll
        for (int r = 0; r < RB; ++r) { float* o = p.out + (long)(row0 + r) * DM;
#pragma unroll
            for (int i = 0; i < 2; ++i) { f32x4 a, b;
#pragma unroll
                for (int j = 0; j < 4; ++j) { a[j] = bf2f(v[r][i][j]) * rs[r] * gv[2 * i][j]; b[j] = bf2f(v[r][i][4 + j]) * rs[r] * gv[2 * i + 1][j]; }
                __builtin_nontemporal_store(a, (f32x4*)(o + lane * 8 + 512 * i)); __builtin_nontemporal_store(b, (f32x4*)(o + lane * 8 + 512 * i + 4)); } }
    }
}

DI void phase_mla_pre(const Params& p, int gw, int nw) {
    unsigned char* ws = p.ws; const int lane = opaque_tid() & 63;
    const bf16_t* proj = (const bf16_t*)(ws + WS_PROJ); bf16_t* cqn = (bf16_t*)(ws + WS_CQN); bf16_t* ckvn = (bf16_t*)(ws + WS_CKVN); bf16_t* kr = (bf16_t*)(ws + WS_KR);
    const float* cs = (const float*)(ws + WS_COS); const float* sn = (const float*)(ws + WS_SIN);
    float gq[8], gk[8];
#pragma unroll
    for (int j = 0; j < 8; ++j) { gq[j] = lane < 48 ? p.q_a_norm_g[lane * 8 + j] : 0.f; gk[j] = lane < 32 ? p.kv_a_norm_g[lane * 8 + j] : 0.f; }
    constexpr int RB = 4;
    for (int row0 = gw * RB; row0 < MTOK; row0 += nw * RB) {
        bf16x8 a[RB], b[RB], x1[RB], x2[RB];
#pragma unroll
        for (int r = 0; r < RB; ++r) { const bf16_t* pr = proj + (long)(row0 + r) * DINP; a[r] = bf16x8{}; b[r] = bf16x8{}; x1[r] = bf16x8{}; x2[r] = bf16x8{};
            if (lane < 48) a[r] = *(const bf16x8*)(pr + C_CQ + lane * 8);
            if (lane < 32) b[r] = *(const bf16x8*)(pr + C_CKV + lane * 8);
            if (lane < 4) { x1[r] = *(const bf16x8*)(pr + C_KR + lane * 8); x2[r] = *(const bf16x8*)(pr + C_KR + 32 + lane * 8); } }
#pragma unroll
        for (int r = 0; r < RB; ++r) { const int row = row0 + r;
            float fa[8], fb[8], sa = 0.f, sb = 0.f;
#pragma unroll
            for (int j = 0; j < 8; ++j) { fa[j] = bf2f(a[r][j]); fb[j] = bf2f(b[r][j]); sa += fa[j] * fa[j]; sb += fb[j] * fb[j]; }
            sa = wave_sum(sa); sb = wave_sum(sb);
            const float ra = rsqrtf(sa * (1.f / QLORA) + EPS), rb = rsqrtf(sb * (1.f / KVLORA) + EPS);
#pragma unroll
            for (int j = 0; j < 8; ++j) { fa[j] *= ra * gq[j]; fb[j] *= rb * gk[j]; }
            if (lane < 48) *(bf16x8*)(cqn + (long)row * QLORA + lane * 8) = pack8(fa);
            if (lane < 32) *(bf16x8*)(ckvn + (long)row * KVLORA + lane * 8) = pack8(fb);
            if (lane < 4) { const int pos = row & (SEQ - 1);
                float o1[8], o2[8];
#pragma unroll
                for (int j = 0; j < 8; ++j) { const float c = cs[pos * 32 + lane * 8 + j], s = sn[pos * 32 + lane * 8 + j], f1 = bf2f(x1[r][j]), f2 = bf2f(x2[r][j]); o1[j] = f1 * c - f2 * s; o2[j] = f1 * s + f2 * c; }
                *(bf16x8*)(kr + (long)row * 64 + lane * 8) = pack8(o1); *(bf16x8*)(kr + (long)row * 64 + 32 + lane * 8) = pack8(o2); }
        }
    }
}

DI void phase_krope(const Params& p, int gw, int nw) {
    unsigned char* ws = p.ws; const int lane = opaque_tid() & 63, rl = lane >> 2, ch = lane & 3;
    const bf16_t* proj = (const bf16_t*)(ws + WS_PROJ); bf16_t* kr = (bf16_t*)(ws + WS_KR);
    const float* cs = (const float*)(ws + WS_COS); const float* sn = (const float*)(ws + WS_SIN);
    for (int row0 = gw * 16; row0 < MTOK; row0 += nw * 16) { const int row = row0 + rl, pos = row & (SEQ - 1);
        const bf16_t* pr = proj + (long)row * DINP + C_KR + ch * 8;
        const bf16x8 x1 = *(const bf16x8*)pr, x2 = *(const bf16x8*)(pr + 32);
        const f32x4 c0 = *(const f32x4*)(cs + pos * 32 + ch * 8), c1 = *(const f32x4*)(cs + pos * 32 + ch * 8 + 4), s0 = *(const f32x4*)(sn + pos * 32 + ch * 8), s1 = *(const f32x4*)(sn + pos * 32 + ch * 8 + 4);
        float o1[8], o2[8];
#pragma unroll
        for (int j = 0; j < 8; ++j) { const float c = j < 4 ? c0[j & 3] : c1[j & 3], s = j < 4 ? s0[j & 3] : s1[j & 3], f1 = bf2f(x1[j]), f2 = bf2f(x2[j]); o1[j] = f1 * c - f2 * s; o2[j] = f1 * s + f2 * c; }
        *(bf16x8*)(kr + (long)row * 64 + ch * 8) = pack8(o1); *(bf16x8*)(kr + (long)row * 64 + 32 + ch * 8) = pack8(o2); }
}

DI void phase_mix_pre(const Params& p, int gw, int nw) {
    unsigned char* ws = p.ws; const int lane = opaque_tid() & 63;
    const bf16_t* proj = (const bf16_t*)(ws + WS_PROJ); const bf16_t* OF = (const bf16_t*)p.out; const bf16_t* OB = OF + (long)MTOK * 512;
    const bf16_t* OA = (const bf16_t*)(ws + WS_OA); bf16_t* Y = (bf16_t*)p.out + (long)MTOK * 1024;
    float gh[8], gm[8];
#pragma unroll
    for (int j = 0; j < 8; ++j) { gh[j] = p.hgrn_norm_g[lane * 8 + j]; gm[j] = p.mla_norm_g[lane * 8 + j]; }
    constexpr int RB = 4;
    for (int row0 = gw * RB; row0 < MTOK; row0 += nw * RB) {
        bf16x8 of[RB], ob[RB], hg[RB], oa[RB];
#pragma unroll
        for (int r = 0; r < RB; ++r) { const long row = row0 + r;
            of[r] = *(const bf16x8*)(OF + row * 512 + lane * 8); ob[r] = *(const bf16x8*)(OB + row * 512 + lane * 8);
            hg[r] = *(const bf16x8*)(proj + row * DINP + C_HG + lane * 8); oa[r] = *(const bf16x8*)(OA + row * 512 + lane * 8); }
#pragma unroll
        for (int r = 0; r < RB; ++r) { const long row = row0 + r;
            float o[8], a[8], so = 0.f, sa = 0.f;
#pragma unroll
            for (int j = 0; j < 8; ++j) { o[j] = bf2f(of[r][j]) + bf2f(ob[r][j]); a[j] = bf2f(oa[r][j]); so += o[j] * o[j]; sa += a[j] * a[j]; }
            so += __shfl_xor(so, 1); so += __shfl_xor(so, 2); so += __shfl_xor(so, 4);
            sa = wave_sum(sa);
            const float ro = rsqrtf(so * (1.f / 64.f) + EPS), ra = rsqrtf(sa * (1.f / 512.f) + EPS);
#pragma unroll
            for (int j = 0; j < 8; ++j) { o[j] = o[j] * ro * gh[j] * bf2f(hg[r][j]);     a[j] = a[j] * ra * gm[j]; }
            *(bf16x8*)(Y + row * DM + lane * 8) = pack8(o); *(bf16x8*)(Y + row * DM + 512 + lane * 8) = pack8(a);
        }
    }
}

constexpr int ATT_SHM_V = 64 * 128 * 2, ATT_SHM_K = 64 * 128 * 2, ATT_SHM_R = 64 * 64 * 2;
constexpr int ATT_OFF_K = 2 * ATT_SHM_V, ATT_OFF_R = ATT_OFF_K + 2 * ATT_SHM_K, ATT_OFF_W = ATT_OFF_R + 2 * ATT_SHM_R, ATT_OFF_Q = ATT_OFF_W + 8 * 64 * 4, ATT_LDS = ATT_OFF_Q + 8 * 4 * 64 * 16;
constexpr float ATT_SCALE = 0.07216878364870322f;
constexpr float ATT_THR = 8.f;
#define KSWZ(row, colB) ((row) * 256 + ((colB) ^ (((row) & 15) << 4)))
#define RSWZ(row, colB) ((row) * 128 + ((colB) ^ ((((row) >> 1) & 7) << 4)))
#define SBAR() __builtin_amdgcn_sched_barrier(0)
DI int crow(int r, int hi) { return (r & 3) + 8 * (r >> 2) + 4 * hi; }

DI void partialSM(f32x16& p0, f32x16& p1, float& m_reg, float& mn, float& alpha) {
    constexpr float C = ATT_SCALE * 1.4426950408889634f;
    float pmax = p0[0];
#pragma unroll
    for (int r = 1; r < 16; ++r) pmax = fmaxf(pmax, p0[r]);
#pragma unroll
    for (int r = 0; r < 16; ++r) pmax = fmaxf(pmax, p1[r]);
    { auto rr = __builtin_amdgcn_permlane32_swap(__float_as_uint(pmax), __float_as_uint(pmax), false, false);
      pmax = fmaxf(__uint_as_float(rr[0]), __uint_as_float(rr[1])); }
    if (__builtin_expect(__all(pmax - m_reg <= ATT_THR / ATT_SCALE), 1)) { mn = m_reg; alpha = 1.f; }
    else { mn = fmaxf(m_reg, pmax); alpha = __builtin_amdgcn_exp2f((m_reg - mn) * C); m_reg = mn; }
    const float mnC = -mn * C;
#pragma unroll
    for (int r = 0; r < 16; ++r) p0[r] = fmaf(p0[r], C, mnC);
#pragma unroll
    for (int r = 0; r < 16; ++r) p1[r] = fmaf(p1[r], C, mnC);
#pragma unroll
    for (int r = 0; r < 16; ++r) p0[r] = __builtin_amdgcn_exp2f(p0[r]);
}
DI void finishSM(f32x16& p0, f32x16& p1, float alpha, float& l_reg, bf16x8& pa0, bf16x8& pa1, bf16x8& pa2, bf16x8& pa3) {
#pragma unroll
    for (int r = 0; r < 16; ++r) p1[r] = __builtin_amdgcn_exp2f(p1[r]);
    float ps = 0;
#pragma unroll
    for (int r = 0; r < 16; ++r) ps += p0[r];
#pragma unroll
    for (int r = 0; r < 16; ++r) ps += p1[r];
    { auto rr = __builtin_amdgcn_permlane32_swap(__float_as_uint(ps), __float_as_uint(ps), false, false);
      ps = __uint_as_float(rr[0]) + __uint_as_float(rr[1]); }
    l_reg = l_reg * alpha + ps;
#define PK4(P, BASE, OUT) do { unsigned a0 = cvtpk(P[BASE + 0], P[BASE + 1]), a1 = cvtpk(P[BASE + 2], P[BASE + 3]);   \
    unsigned b0 = cvtpk(P[BASE + 4], P[BASE + 5]), b1 = cvtpk(P[BASE + 6], P[BASE + 7]);                              \
    auto r0 = __builtin_amdgcn_permlane32_swap(a0, b0, false, false); auto r1 = __builtin_amdgcn_permlane32_swap(a1, b1, false, false); \
    u32x4 w = {r0[0], r1[0], r0[1], r1[1]}; OUT = __builtin_bit_cast(bf16x8, w); } while (0)
    PK4(p0, 0, pa0); PK4(p0, 8, pa1); PK4(p1, 0, pa2); PK4(p1, 8, pa3);
#undef PK4
}
DI void qkt(f32x16& p0, f32x16& p1, const LAS char* Ks, const LAS char* Rs, const bf16x8* qr, const LAS bf16x8* qrl, int r32, int hi) {
    p0 = f32x16{}; p1 = f32x16{};
#pragma unroll
    for (int d0 = 0; d0 < 8; ++d0) { const int cb = (d0 * 16 + hi * 8) * 2;
        const bf16x8 b0 = *reinterpret_cast<const LAS bf16x8*>(Ks + KSWZ(r32, cb));
        const bf16x8 b1 = *reinterpret_cast<const LAS bf16x8*>(Ks + KSWZ(32 + r32, cb));
        p0 = __builtin_amdgcn_mfma_f32_32x32x16_bf16(b0, qr[d0], p0, 0, 0, 0);
        p1 = __builtin_amdgcn_mfma_f32_32x32x16_bf16(b1, qr[d0], p1, 0, 0, 0); }
#pragma unroll
    for (int d0 = 0; d0 < 4; ++d0) { const int cb = (d0 * 16 + hi * 8) * 2;
        const bf16x8 b0 = *reinterpret_cast<const LAS bf16x8*>(Rs + RSWZ(r32, cb));
        const bf16x8 b1 = *reinterpret_cast<const LAS bf16x8*>(Rs + RSWZ(32 + r32, cb));
        const bf16x8 qv = qrl[d0 * 64];
        p0 = __builtin_amdgcn_mfma_f32_32x32x16_bf16(b0, qv, p0, 0, 0, 0);
        p1 = __builtin_amdgcn_mfma_f32_32x32x16_bf16(b1, qv, p1, 0, 0, 0); }
}
DI int v_st(int k, int c) { const int kk = (k & ~0xC) | ((k & 4) << 1) | ((k & 8) >> 1); return ((kk >> 3) * 4 + (c >> 5)) * 512 + ((kk & 7) * 32 + (c & 31)) * 2; }
DI int v_rd_base(int lane) { return ((lane & 3) << 3) | (((lane >> 2) & 3) << 6) | (((lane >> 4) & 1) << 5) | (((lane >> 5) & 1) << 8); }
constexpr int v_rd_off(int d0, int ks, int half) { return d0 * 512 + ks * 4096 + half * 2048; }
template <int OFF> DI s16x4 tr_read(int vb) { s16x4 r; asm volatile("ds_read_b64_tr_b16 %0, %1 offset:%2" : "=&v"(r) : "v"(vb), "i"(OFF) : "memory"); return r; }
template <int D0> DI void pv_one(f32x16& od, int vb, bf16x8 pa0, bf16x8 pa1, bf16x8 pa2, bf16x8 pa3) {
    const s16x4 l0 = tr_read<v_rd_off(D0, 0, 0)>(vb), h0 = tr_read<v_rd_off(D0, 0, 1)>(vb), l1 = tr_read<v_rd_off(D0, 1, 0)>(vb), h1 = tr_read<v_rd_off(D0, 1, 1)>(vb);
    const s16x4 l2 = tr_read<v_rd_off(D0, 2, 0)>(vb), h2 = tr_read<v_rd_off(D0, 2, 1)>(vb), l3 = tr_read<v_rd_off(D0, 3, 0)>(vb), h3 = tr_read<v_rd_off(D0, 3, 1)>(vb);
    asm volatile("s_waitcnt lgkmcnt(0)" ::: "memory"); SBAR();
#define PK(L, H) (bf16x8){L[0], L[1], L[2], L[3], H[0], H[1], H[2], H[3]}
    od = __builtin_amdgcn_mfma_f32_32x32x16_bf16(pa0, PK(l0, h0), od, 0, 0, 0);
    od = __builtin_amdgcn_mfma_f32_32x32x16_bf16(pa1, PK(l1, h1), od, 0, 0, 0);
    od = __builtin_amdgcn_mfma_f32_32x32x16_bf16(pa2, PK(l2, h2), od, 0, 0, 0);
    od = __builtin_amdgcn_mfma_f32_32x32x16_bf16(pa3, PK(l3, h3), od, 0, 0, 0);
#undef PK
}
DI void pv_d0(f32x16* o, int vb, bf16x8 pa0, bf16x8 pa1, bf16x8 pa2, bf16x8 pa3) {
    pv_one<0>(o[0], vb, pa0, pa1, pa2, pa3); pv_one<1>(o[1], vb, pa0, pa1, pa2, pa3); pv_one<2>(o[2], vb, pa0, pa1, pa2, pa3); pv_one<3>(o[3], vb, pa0, pa1, pa2, pa3);
}

DI void attn_unit(const bf16_t* __restrict__ QB, const bf16_t* __restrict__ KVb, const bf16_t* __restrict__ KRb, const float* __restrict__ cs, const float* __restrict__ sn,
                  bf16_t* __restrict__ OA, int b, int h, int i0, LAS char* lds) {
    const int tid = opaque_tid(), wid = tid >> 6, lane = tid & 63, r32 = lane & 31, hi = lane >> 5;
    LAS char* V_lds = lds; LAS char* K_lds = lds + ATT_OFF_K; LAS char* R_lds = lds + ATT_OFF_R;
    LAS float* wsl = (LAS float*)(lds + ATT_OFF_W) + wid * 64; LAS float* li_l = wsl; LAS float* al_l = wsl + 32;
    float m_reg = -1e30f, l_reg = 0; f32x16 o[4] = {}; bf16x8 qr[8];
    const int pos = i0 + wid * 32 + r32;
    const bf16_t* Qw = QB + ((long)b * SEQ + pos) * QW + h * 192 + hi * 8;
    LAS bf16x8* qrl = (LAS bf16x8*)(lds + ATT_OFF_Q) + wid * 256 + lane;
#pragma unroll
    for (int d0 = 0; d0 < 8; ++d0) qr[d0] = *(const bf16x8*)(Qw + d0 * 16);
#pragma unroll
    for (int a = 0; a < 2; ++a) {
        const bf16x8 x1 = *(const bf16x8*)(Qw + (8 + a) * 16), x2 = *(const bf16x8*)(Qw + (10 + a) * 16);
        const float* cp = cs + pos * 32 + 16 * a + 8 * hi; const float* sp = sn + pos * 32 + 16 * a + 8 * hi;
        float o1[8], o2[8];
#pragma unroll
        for (int j = 0; j < 8; ++j) { const float c = cp[j], s = sp[j], f1 = bf2f(x1[j]), f2 = bf2f(x2[j]); o1[j] = f1 * c - f2 * s; o2[j] = f1 * s + f2 * c; }
        qrl[a * 64] = pack8(o1); qrl[(2 + a) * 64] = pack8(o2);
    }
    const bf16_t* Kh = KVb + (long)b * SEQ * KVW + h * 256; const bf16_t* Vh = Kh + 128; const bf16_t* Rh = KRb + (long)b * SEQ * 64;
    const int sr = tid >> 4, sc = (tid & 15) * 8, vst0 = v_st(sr, sc), vst1 = v_st(32 + sr, sc);
    const int rr = tid >> 3, rc = (tid & 7) * 8;
    const int vb0 = (int)(uintptr_t)V_lds + v_rd_base(lane);
    bf16x8 vs0, vs1, ks0, ks1, rs0;
    const unsigned so0 = (unsigned)(sr * KVW + sc) * 2u, so1 = so0 + 32u * KVW * 2u, sor = (unsigned)(rr * 64 + rc) * 2u;
#define SLOAD(k0) do { const char* _vb = (const char*)(Vh + (long)(k0) * KVW); const char* _rb = (const char*)(Rh + (long)(k0) * 64); \
    vs0 = *(const bf16x8*)(_vb + so0); vs1 = *(const bf16x8*)(_vb + so1); \
    ks0 = *(const bf16x8*)(_vb + so0 - 256); ks1 = *(const bf16x8*)(_vb + so1 - 256); \
    rs0 = *(const bf16x8*)(_rb + sor); } while (0)
#define SWRITE(bi) do { *(LAS bf16x8*)(V_lds + (bi) * ATT_SHM_V + vst0) = vs0; *(LAS bf16x8*)(V_lds + (bi) * ATT_SHM_V + vst1) = vs1; const int kc = sc * 2; \
    *(LAS bf16x8*)(K_lds + (bi) * ATT_SHM_K + KSWZ(sr, kc)) = ks0; *(LAS bf16x8*)(K_lds + (bi) * ATT_SHM_K + KSWZ(32 + sr, kc)) = ks1; \
    *(LAS bf16x8*)(R_lds + (bi) * ATT_SHM_R + RSWZ(rr, rc * 2)) = rs0; } while (0)
#define RESC(a) do { if (__any((a) < 1.f)) { if (hi == 0) al_l[r32] = (a); asm volatile("s_waitcnt lgkmcnt(0)" ::: "memory"); \
    _Pragma("unroll") for (int d = 0; d < 4; ++d) _Pragma("unroll") for (int r = 0; r < 16; ++r) o[d][r] *= al_l[crow(r, hi)]; } } while (0)
    f32x16 pA0, pA1, pB0, pB1; float mnA, mnB, alA, alB; bf16x8 pa0, pa1, pa2, pa3; constexpr int NT = SEQ / 64;
    SLOAD(0); SWRITE(0); __syncthreads();
    qkt(pA0, pA1, K_lds, R_lds, qr, qrl, r32, hi); partialSM(pA0, pA1, m_reg, mnA, alA);
    SLOAD(64); SWRITE(1); __syncthreads();
    for (int j = 1; j + 1 < NT; j += 2) {
        SBAR(); qkt(pB0, pB1, K_lds + ATT_SHM_K, R_lds + ATT_SHM_R, qr, qrl, r32, hi);
        finishSM(pA0, pA1, alA, l_reg, pa0, pa1, pa2, pa3); SBAR();
        SLOAD((j + 1) * 64); SBAR();
        pv_d0(o, vb0, pa0, pa1, pa2, pa3); partialSM(pB0, pB1, m_reg, mnB, alB);
        __syncthreads(); SWRITE(0);
        RESC(alB); __syncthreads();
        SBAR(); qkt(pA0, pA1, K_lds, R_lds, qr, qrl, r32, hi);
        finishSM(pB0, pB1, alB, l_reg, pa0, pa1, pa2, pa3); SBAR();
        SLOAD((j + 2) * 64); SBAR();
        pv_d0(o, vb0 + ATT_SHM_V, pa0, pa1, pa2, pa3); partialSM(pA0, pA1, m_reg, mnA, alA);
        __syncthreads(); SWRITE(1);
        RESC(alA); __syncthreads();
    }
    SBAR(); qkt(pB0, pB1, K_lds + ATT_SHM_K, R_lds + ATT_SHM_R, qr, qrl, r32, hi);
    finishSM(pA0, pA1, alA, l_reg, pa0, pa1, pa2, pa3); SBAR();
    pv_d0(o, vb0, pa0, pa1, pa2, pa3); partialSM(pB0, pB1, m_reg, mnB, alB);
    __syncthreads(); RESC(alB);
    finishSM(pB0, pB1, alB, l_reg, pa0, pa1, pa2, pa3); SBAR();
    pv_d0(o, vb0 + ATT_SHM_V, pa0, pa1, pa2, pa3);
    if (hi == 0) li_l[r32] = l_reg; asm volatile("s_waitcnt lgkmcnt(0)" ::: "memory");
    float rli[16];
#pragma unroll
    for (int r = 0; r < 16; ++r) rli[r] = __builtin_amdgcn_rcpf(li_l[crow(r, hi)]);
    bf16_t* Ow = OA + ((long)b * SEQ + i0 + wid * 32) * 512 + h * 128;
#pragma unroll
    for (int r = 0; r < 16; ++r) { const int orow = crow(r, hi);
#pragma unroll
        for (int d0 = 0; d0 < 4; ++d0) { const float v = o[d0][r] * rli[r]; __builtin_nontemporal_store((bf16_t)(cvtpk(v, v) & 0xffffu), Ow + (long)orow * 512 + d0 * 32 + r32); } }
#undef SLOAD
#undef SWRITE
#undef RESC
}

constexpr int HG_LD = 80;
constexpr int HG_TILE = 64 * HG_LD * 2;
constexpr int HG_QD = 0, HG_KI = HG_TILE, HG_KET = 2 * HG_TILE, HG_VT = 3 * HG_TILE, HG_PP = 4 * HG_TILE, HG_ST = 5 * HG_TILE, HG_TOT = 6 * HG_TILE, HG_DEC = HG_TOT + 8 * 64 * 4, HG_RAW = ((HG_DEC + 512 + 1023) / 1024) * 1024, HG_LDS = HG_RAW + 3 * 8192;

DI void hgrn_item(const Params& p, int item, LAS char* lds) {
    const int tid = opaque_tid(), lane = tid & 63, wid = tid >> 6, fr = lane & 15, fq = lane >> 4;
    const int dir = item & 1, h = (item >> 1) & 7, b = item >> 4;
    const bf16_t* proj = (const bf16_t*)(p.ws + WS_PROJ) + (long)b * SEQ * DINP;
    bf16_t* O = (bf16_t*)p.out + (long)dir * MTOK * 512 + (long)b * SEQ * 512 + h * 64;
    const int i = lane, dc = wid * 8;
    const int li = tid >> 3, lch = tid & 7;
    const int colq = C_HQ + h * 64 + lch * 8, colv = C_HI + h * 64 + lch * 8, colf = C_HF + dir * 512 + h * 64 + lch * 8;
    LAS char* RAW = lds + HG_RAW;
    const int raw_wr = li * 128 + ((lch ^ ((li >> 1) & 7)) << 4), raw_rd = i * 128 + ((wid ^ ((i >> 1) & 7)) << 4);
    LAS bf16_t* QD = (LAS bf16_t*)(lds + HG_QD); LAS bf16_t* KI = (LAS bf16_t*)(lds + HG_KI); LAS bf16_t* KET = (LAS bf16_t*)(lds + HG_KET);
    LAS bf16_t* VT = (LAS bf16_t*)(lds + HG_VT); LAS bf16_t* PP = (LAS bf16_t*)(lds + HG_PP); LAS bf16_t* ST = (LAS bf16_t*)(lds + HG_ST);
    LAS float* DEC = (LAS float*)(lds + HG_DEC);
    const int tm = wid >> 1, tn0 = (wid & 1) * 2;
    f32x4 S[2] = {};
    __syncthreads();
#pragma unroll
    for (int t = 0; t < 2; ++t) *(LAS u32x2*)(ST + (16 * (tn0 + t) + fr) * HG_LD + 16 * tm + 4 * fq) = (u32x2){0u, 0u};
    bf16x8 rq, rf, rv;
    { const int c = dir ? 63 : 0; const long row = (long)c * 64 + (dir ? 63 - li : li); const bf16_t* pr = proj + row * DINP;
      rq = *(const bf16x8*)(pr + colq); rf = *(const bf16x8*)(pr + colf); rv = *(const bf16x8*)(pr + colv); }
    for (int n = 0; n < 64; ++n) {
        const int c = dir ? 63 - n : n;
        bf16x8 nq = rq, nf = rf, nv = rv;
        if (n + 1 < 64) { const int c2 = dir ? c - 1 : c + 1; const long row = (long)c2 * 64 + (dir ? 63 - li : li); const bf16_t* pr = proj + row * DINP;
            nq = *(const bf16x8*)(pr + colq); nf = *(const bf16x8*)(pr + colf); nv = *(const bf16x8*)(pr + colv); }
        *(LAS bf16x8*)(RAW + raw_wr) = rq; *(LAS bf16x8*)(RAW + 8192 + raw_wr) = rf; *(LAS bf16x8*)(RAW + 16384 + raw_wr) = rv;
        __syncthreads();
        const bf16x8 xq = *(const LAS bf16x8*)(RAW + raw_rd), xf = *(const LAS bf16x8*)(RAW + 8192 + raw_rd), xv = *(const LAS bf16x8*)(RAW + 16384 + raw_rd);
        float P[8], kk[8];
#pragma unroll
        for (int j = 0; j < 8; ++j) { kk[j] = bf2f(xf[j]); P[j] = 1.f - kk[j]; }
#define DPP_MUL(CTRL, RMASK) _Pragma("unroll") for (int j = 0; j < 8; ++j) { \
            const float t = __builtin_bit_cast(float, __builtin_amdgcn_update_dpp(0x3f800000, __builtin_bit_cast(int, P[j]), CTRL, RMASK, 0xF, false)); P[j] *= t; }
        DPP_MUL(0x111, 0xF) DPP_MUL(0x112, 0xF) DPP_MUL(0x114, 0xF) DPP_MUL(0x118, 0xF) DPP_MUL(0x142, 0xA) DPP_MUL(0x143, 0xC)
#undef DPP_MUL
        float qd[8], ki[8];
#pragma unroll
        for (int j = 0; j < 8; ++j) { const float plast = __builtin_bit_cast(float, __builtin_amdgcn_readlane(__builtin_bit_cast(int, P[j]), 63)); const float sq = bf2f(xq[j]);
            const float rp = __builtin_amdgcn_rcpf(P[j]);
            qd[j] = sq * P[j]; ki[j] = kk[j] * rp; const float ke = ki[j] * plast;
            KET[(dc + j) * HG_LD + i] = (bf16_t)(cvtpk(ke, ke) & 0xffffu); VT[(dc + j) * HG_LD + i] = (bf16_t)xv[j];
            if (lane == 0) DEC[(n & 1) * 64 + dc + j] = plast; }
        *(LAS bf16x8*)(QD + i * HG_LD + dc) = pack8(qd); *(LAS bf16x8*)(KI + i * HG_LD + dc) = pack8(ki);
        __syncthreads();
        bf16x8 QDf[2], KETf[2], KIf[2][2], VTf[2][2], STf[2][2];
#pragma unroll
        for (int ks = 0; ks < 2; ++ks) {
            QDf[ks] = *(const LAS bf16x8*)(QD + (16 * tm + fr) * HG_LD + 32 * ks + 8 * fq);
            KETf[ks] = *(const LAS bf16x8*)(KET + (16 * tm + fr) * HG_LD + 32 * ks + 8 * fq);
#pragma unroll
            for (int t = 0; t < 2; ++t) { const int rw = (16 * (tn0 + t) + fr) * HG_LD + 32 * ks + 8 * fq;
                KIf[t][ks] = *(const LAS bf16x8*)(KI + rw); VTf[t][ks] = *(const LAS bf16x8*)(VT + rw); STf[t][ks] = *(const LAS bf16x8*)(ST + rw); } }
        f32x4 sc[2] = {}, u[2] = {}, oT[2] = {};
#pragma unroll
        for (int t = 0; t < 2; ++t)
#pragma unroll
            for (int ks = 0; ks < 2; ++ks) {
                sc[t] = __builtin_amdgcn_mfma_f32_16x16x32_bf16(KIf[t][ks], QDf[ks], sc[t], 0, 0, 0);
                u[t]  = __builtin_amdgcn_mfma_f32_16x16x32_bf16(KETf[ks], VTf[t][ks], u[t], 0, 0, 0);
                oT[t] = __builtin_amdgcn_mfma_f32_16x16x32_bf16(STf[t][ks], QDf[ks], oT[t], 0, 0, 0);
            }
#pragma unroll
        for (int t = 0; t < 2; ++t) { const int ii = 16 * tm + fr, j0 = 16 * (tn0 + t) + 4 * fq;
            float m[4];
#pragma unroll
            for (int r = 0; r < 4; ++r) m[r] = (j0 + r <= ii) ? sc[t][r] : 0.f;
            *(LAS u32x2*)(PP + ii * HG_LD + j0) = (u32x2){cvtpk(m[0], m[1]), cvtpk(m[2], m[3])}; }
        __syncthreads();
        bf16x8 PPf[2];
#pragma unroll
        for (int ks = 0; ks < 2; ++ks) PPf[ks] = *(const LAS bf16x8*)(PP + (16 * tm + fr) * HG_LD + 32 * ks + 8 * fq);
#pragma unroll
        for (int t = 0; t < 2; ++t)
#pragma unroll
            for (int ks = 0; ks < 2; ++ks) oT[t] = __builtin_amdgcn_mfma_f32_16x16x32_bf16(VTf[t][ks], PPf[ks], oT[t], 0, 0, 0);
        { const long orow = (long)c * 64 + (dir ? 63 - (16 * tm + fr) : (16 * tm + fr));
#pragma unroll
          for (int t = 0; t < 2; ++t) __builtin_nontemporal_store((u32x2){cvtpk(oT[t][0], oT[t][1]), cvtpk(oT[t][2], oT[t][3])}, (u32x2*)(O + orow * 512 + 16 * (tn0 + t) + 4 * fq)); }
        const f32x4 dcy = *(const LAS f32x4*)(DEC + (n & 1) * 64 + 16 * tm + 4 * fq);
#pragma unroll
        for (int t = 0; t < 2; ++t) { S[t] = dcy * S[t] + u[t];
            *(LAS u32x2*)(ST + (16 * (tn0 + t) + fr) * HG_LD + 16 * tm + 4 * fq) = (u32x2){cvtpk(S[t][0], S[t][1]), cvtpk(S[t][2], S[t][3])}; }
        rq = nq; rf = nf; rv = nv;
    }
}

DI void hgrn_item_naive(const Params& p, int item, LAS char* lds) {
    const int tid = threadIdx.x; const int d = tid >> 3, e0 = (tid & 7) * 8;
    const int dir = item & 1, h = (item >> 1) & 7, b = item >> 4;
    const bf16_t* proj = (const bf16_t*)(p.ws + WS_PROJ) + (long)b * SEQ * DINP;
    bf16_t* O = (bf16_t*)p.out + (long)dir * MTOK * 512 + (long)b * SEQ * 512 + h * 64;
    const float a0 = p.lb_logits[dir * 1024 + h * 64 + d], a1 = p.lb_logits[dir * 1024 + 512 + h * 64 + d];
    const float lb = 1.f / (1.f + expf(a1 - a0));
    float S[8] = {0, 0, 0, 0, 0, 0, 0, 0};
    LAS float* part = (LAS float*)lds;
    __syncthreads();
    for (int n = 0; n < SEQ; ++n) {
        const int t = dir ? SEQ - 1 - n : n;
        const bf16_t* pr = proj + (long)t * DINP;
        const float z = bf2f((short)pr[C_HF + dir * 512 + h * 64 + d]); const float sig = 1.f / (1.f + expf(-z));
        const float f = lb + (1.f - lb) * sig; const float k = (1.f - lb) * (1.f / (1.f + expf(z)));
        float q = bf2f((short)pr[C_HQ + h * 64 + d]); q = q / (1.f + expf(-q));
        const bf16x8 vv = *(const bf16x8*)(pr + C_HI + h * 64 + e0);
#pragma unroll
        for (int j = 0; j < 8; ++j) { const float v = bf2f(vv[j]); S[j] = f * S[j] + k * v; part[d * 64 + e0 + j] = S[j] * q; }
        __syncthreads();
        if (tid < 64) { float o = 0.f;
#pragma unroll 8
            for (int dd = 0; dd < 64; ++dd) o += part[dd * 64 + tid];
            O[(long)t * 512 + tid] = (bf16_t)(cvtpk(o, o) & 0xffffu); }
        __syncthreads();
    }
}

DI void dbg_hgrn(const Params& p, LAS char* lds, int dir, unsigned* flag, unsigned bit) {
    const int tid = threadIdx.x; const int d = tid >> 3, e0 = (tid & 7) * 8;
    const int b = 1, h = 3;
    const bf16_t* proj = (const bf16_t*)(p.ws + WS_PROJ) + (long)b * SEQ * DINP;
    const bf16_t* O = (const bf16_t*)p.out + (long)dir * MTOK * 512 + (long)b * SEQ * 512 + h * 64;
    const float a0 = p.lb_logits[dir * 1024 + h * 64 + d], a1 = p.lb_logits[dir * 1024 + 512 + h * 64 + d];
    const float lb = 1.f / (1.f + expf(a1 - a0));
    float S[8] = {0, 0, 0, 0, 0, 0, 0, 0};
    LAS float* part = (LAS float*)lds;
    float maxdiff = 0.f, maxref = 0.f;
    __syncthreads();
    for (int n = 0; n < 512; ++n) {
        const int t = dir ? SEQ - 1 - n : n;
        const bf16_t* pr = proj + (long)t * DINP;
        const float z = bf2f((short)pr[C_HF + dir * 512 + h * 64 + d]); const float sig = 1.f / (1.f + expf(-z));
        const float f = lb + (1.f - lb) * sig; const float k = (1.f - lb) * (1.f / (1.f + expf(z)));
        float q = bf2f((short)pr[C_HQ + h * 64 + d]); q = q / (1.f + expf(-q));
#pragma unroll
        for (int j = 0; j < 8; ++j) { const float v = bf2f((short)pr[C_HI + h * 64 + e0 + j]); S[j] = f * S[j] + k * v; part[d * 64 + e0 + j] = S[j] * q; }
        __syncthreads();
        if (tid < 64) { float o = 0.f; for (int dd = 0; dd < 64; ++dd) o += part[dd * 64 + tid]; const float fast = bf2f((short)O[(long)t * 512 + tid]);
            maxdiff = fmaxf(maxdiff, fabsf(o - fast)); maxref = fmaxf(maxref, fabsf(o)); }
        __syncthreads();
    }
    if (tid < 64) {
#pragma unroll
        for (int o = 32; o > 0; o >>= 1) { maxdiff = fmaxf(maxdiff, __shfl_xor(maxdiff, o)); maxref = fmaxf(maxref, __shfl_xor(maxref, o)); }
        if (tid == 0 && !(maxdiff <= 0.03f * maxref)) atomicOr(flag, bit);
    }
    __syncthreads();
}
DI void dbg_attn(const Params& p, LAS char* lds, unsigned* flag, unsigned bit) {
    const int tid = threadIdx.x, row = tid >> 3, e0 = (tid & 7) * 16;
    const int b = 2, h = 1, r0 = 1000;
    const bf16_t* QB = (const bf16_t*)(p.ws + WS_QB); const bf16_t* KV = (const bf16_t*)(p.ws + WS_KV); const bf16_t* KR = (const bf16_t*)(p.ws + WS_KR);
    const bf16_t* OA = (const bf16_t*)(p.ws + WS_OA); const float* cs = (const float*)(p.ws + WS_COS); const float* sn = (const float*)(p.ws + WS_SIN);
    LAS float* qs = (LAS float*)lds;
    __syncthreads();
    for (int idx = tid; idx < 64 * 192; idx += 512) { const int rw = idx / 192, dd = idx % 192, pos = r0 + rw; const bf16_t* qp = QB + ((long)b * SEQ + pos) * QW + h * 192;
        float val = bf2f((short)qp[dd]);
        if (dd >= 128) { const int i = (dd - 128) & 31; const float x1 = bf2f((short)qp[128 + i]), x2 = bf2f((short)qp[160 + i]), c = cs[pos * 32 + i], s = sn[pos * 32 + i];
            val = (dd - 128 < 32) ? x1 * c - x2 * s : x1 * s + x2 * c; }
        qs[idx] = val; }
    __syncthreads();
    float m = -1e30f, l = 0.f, o[16];
#pragma unroll
    for (int j = 0; j < 16; ++j) o[j] = 0.f;
    for (int key = 0; key < SEQ; ++key) {
        const bf16_t* Kp = KV + ((long)b * SEQ + key) * KVW + h * 256; const bf16_t* Rp = KR + ((long)b * SEQ + key) * 64;
        float s = 0.f;
        for (int dd = 0; dd < 128; ++dd) s += qs[row * 192 + dd] * bf2f((short)Kp[dd]);
        for (int dd = 0; dd < 64; ++dd) s += qs[row * 192 + 128 + dd] * bf2f((short)Rp[dd]);
        s *= ATT_SCALE;
        const float mn = fmaxf(m, s), alpha = expf(m - mn), pe = expf(s - mn); l = l * alpha + pe; m = mn;
#pragma unroll
        for (int j = 0; j < 16; ++j) o[j] = o[j] * alpha + pe * bf2f((short)Kp[128 + e0 + j]);
    }
    float maxdiff = 0.f, maxref = 0.f;
#pragma unroll
    for (int j = 0; j < 16; ++j) { const float ref = o[j] / l, fast = bf2f((short)OA[((long)b * SEQ + r0 + row) * 512 + h * 128 + e0 + j]);
        maxdiff = fmaxf(maxdiff, fabsf(ref - fast)); maxref = fmaxf(maxref, fabsf(ref)); }
#pragma unroll
    for (int of = 32; of > 0; of >>= 1) { maxdiff = fmaxf(maxdiff, __shfl_xor(maxdiff, of)); maxref = fmaxf(maxref, __shfl_xor(maxref, of)); }
    if ((tid & 63) == 0 && !(maxdiff <= 0.03f * maxref)) atomicOr(flag, bit);
    __syncthreads();
}


#define XB_TMO      128
#define XB_XCNT(j)  (256  + 64 * (j))
#define XB_XSUB(j)  (1280 + 64 * (j))
#define XB_XGEN(j)  (2304 + 64 * (j))
#define XB_TOP      3328
#define XB_TOPGEN   3392
#define XCD_BAR_WORDS 3456
#define XB_SPIN_CAP (1u << 20)
DI unsigned xb_ld(unsigned* p)              { return __hip_atomic_load(p, __ATOMIC_RELAXED, __HIP_MEMORY_SCOPE_AGENT); }
DI unsigned xb_add(unsigned* p, unsigned v) { return __hip_atomic_fetch_add(p, v, __ATOMIC_RELAXED, __HIP_MEMORY_SCOPE_AGENT); }
DI unsigned xb_xcc_id() { return (unsigned)__builtin_amdgcn_s_getreg((3 << 11) | 20) & 0xFu; }
#define XB_SPIN(cond, bar) do { unsigned _sp = 0; while (cond) { __builtin_amdgcn_s_sleep(1); \
    if ((++_sp & 255u) == 0u) { if (xb_ld(&(bar)[XB_TMO])) break; if (_sp > XB_SPIN_CAP) { atomicAdd(&(bar)[XB_TMO], 1u); break; } } } } while (0)
struct XcdBarrier { unsigned* bar; unsigned x; volatile LAS unsigned* st; };
DI XcdBarrier xcd_barrier_post(unsigned* bar, volatile LAS unsigned* st) {
    XcdBarrier b; b.bar = bar; b.x = xb_xcc_id(); b.st = st;
    if (threadIdx.x == 0) (void)xb_add(&bar[XB_XCNT(b.x)], 1u);
    return b;
}
DI void xcd_barrier_complete(unsigned* bar, unsigned x, unsigned& nloc, unsigned& nx) {
    const unsigned G = gridDim.x * gridDim.y * gridDim.z;
    unsigned sum, cnt, mine, sp = 0u;
    for (;;) {
        sum = 0u; cnt = 0u; mine = 0u;
#pragma unroll
        for (unsigned j = 0; j < 16; ++j) { const unsigned c = xb_ld(&bar[XB_XCNT(j)]); sum += c; cnt += (c > 0u) ? 1u : 0u; mine = (j == x) ? c : mine; }
        if (sum == G) break;
        __builtin_amdgcn_s_sleep(1);
        if ((++sp & 255u) == 0u) { if (xb_ld(&bar[XB_TMO])) break; if (sp > XB_SPIN_CAP) { atomicAdd(&bar[XB_TMO], 1u); break; } }
    }
    nloc = mine > 0u ? mine : 1u; nx = cnt > 0u ? cnt : 1u;
}
DI void xcd_barrier(const XcdBarrier& b) {
    asm volatile("s_waitcnt vmcnt(0)" ::: "memory");
    __syncthreads();
    if (threadIdx.x == 0) {
        unsigned* bar = b.bar;
        __builtin_amdgcn_s_waitcnt(0);
        unsigned nloc = b.st[0], nx = b.st[1];
        if (nloc == 0u) { xcd_barrier_complete(bar, b.x, nloc, nx); b.st[0] = nloc; b.st[1] = nx; }
        const unsigned old = xb_add(&bar[XB_XSUB(b.x)], 1u);
        const unsigned gen = old / nloc;
        if (old + 1u == (gen + 1u) * nloc) {
            __builtin_amdgcn_fence(__ATOMIC_RELEASE, "agent");
            asm volatile("s_waitcnt vmcnt(0)" ::: "memory");
            const unsigned og = xb_add(&bar[XB_TOP], 1u);
            const unsigned tg = og / nx;
            if (og + 1u == (tg + 1u) * nx) xb_add(&bar[XB_TOPGEN], 1u);
            else XB_SPIN(xb_ld(&bar[XB_TOPGEN]) == tg, bar);
            __builtin_amdgcn_fence(__ATOMIC_ACQUIRE, "agent");
            xb_add(&bar[XB_XGEN(b.x)], 1u);
            asm volatile("s_waitcnt vmcnt(0)" ::: "memory");
        } else {
            XB_SPIN(xb_ld(&bar[XB_XGEN(b.x)]) == gen, bar);
            __builtin_amdgcn_fence(__ATOMIC_ACQUIRE, "agent");
            asm volatile("s_waitcnt vmcnt(0)" ::: "memory");
        }
    }
    __syncthreads();
}
constexpr size_t WS_BAR = WS_END;
static_assert(WS_BAR + XCD_BAR_WORDS * 4 <= (size_t)1 << 30, "barrier words");

constexpr int LDS_BYTES = GEMM_LDS + 256 + 2048;
static_assert(ATT_LDS <= LDS_BYTES && HG_LDS <= LDS_BYTES, "LDS");

__global__ void __launch_bounds__(512) mega_fwd(Params p) {
    extern __shared__ __attribute__((aligned(16))) char dyn_lds[];
    LAS char* lds = (LAS char*)dyn_lds;
    cg::grid_group grid = cg::this_grid();
    unsigned char* ws = p.ws;
    const int nw = gridDim.x * 8;
    volatile LAS unsigned* xst = (volatile LAS unsigned*)(lds + GEMM_LDS);
    if (threadIdx.x == 0) { xst[0] = 0u; xst[1] = 0u; }
    __syncthreads();
    const XcdBarrier xb = xcd_barrier_post((unsigned*)(ws + WS_BAR), xst);
#ifndef PHASE_MASK
#define PHASE_MASK 0xFFFF
#endif
#define PH(k) if constexpr ((PHASE_MASK >> (k)) & 1)
    unsigned* dbgflag = (unsigned*)(ws + WS_END);
    if (blockIdx.x == 0 && threadIdx.x == 0) *dbgflag = 0u;
    PH(0) phase0(p, fresh_gw(), nw);
    if (p.ws == nullptr) grid.sync();
    xcd_barrier(xb);
    PH(1) gemm_phase((const bf16_t*)(ws + WS_H), DM, (const bf16_t*)(ws + WS_WIN), DM, MTOK / BM, DINP / BM, EpiProj{(bf16_t*)(ws + WS_PROJ), (float*)(ws + WS_SSQQ), (float*)(ws + WS_SSQKV), (const float*)(ws + WS_OML), (const float*)(ws + WS_SSQ0)}, lds);
    xcd_barrier(xb);
    PH(2) phase_krope(p, fresh_gw(), nw);
    PH(11) for (int it = blockIdx.x; it < NBATCH * 8 * 2; it += gridDim.x) hgrn_item(p, it, lds);
    __syncthreads();
    PH(3) {
    gemm_phase((const bf16_t*)(ws + WS_PROJ) + C_CQ, DINP, (const bf16_t*)(ws + WS_WQB), QLORA, MTOK / BM, QW / BM, EpiBf16Scale{(bf16_t*)(ws + WS_QB), QW, (const float*)(ws + WS_SSQQ), 1.f / QLORA}, lds);
    gemm_phase((const bf16_t*)(ws + WS_PROJ) + C_CKV, DINP, (const bf16_t*)(ws + WS_WKVB), KVLORA, MTOK / BM, KVW / BM, EpiBf16Scale{(bf16_t*)(ws + WS_KV), KVW, (const float*)(ws + WS_SSQKV), 1.f / KVLORA}, lds);
    }
    xcd_barrier(xb);
    PH(4) for (int u = blockIdx.x; u < NBATCH * 4 * (SEQ / 256); u += gridDim.x) {
        const int cbk = (int)blockIdx.x, rnd = u / (int)gridDim.x, xcd = cbk & 7, idx = cbk >> 3;
        const int pair = (gridDim.x == 256) ? rnd * 16 + xcd * 2 + (idx >> 4) : (u >> 4), qb = (gridDim.x == 256) ? (idx & 15) : (u & 15), h = pair & 3, b = pair >> 2;
        __syncthreads();
        attn_unit((const bf16_t*)(ws + WS_QB), (const bf16_t*)(ws + WS_KV), (const bf16_t*)(ws + WS_KR), (const float*)(ws + WS_COS), (const float*)(ws + WS_SIN),
                  (bf16_t*)(ws + WS_OA), b, h, qb * 256, lds);
    }
    xcd_barrier(xb);
    PH(5) phase_mix_pre(p, fresh_gw(), nw);
    xcd_barrier(xb);
    PH(6) gemm_phase((const bf16_t*)p.out + (long)MTOK * 1024, DM, (const bf16_t*)(ws + WS_WOUT), DM, MTOK / BM, DM / BM, EpiResid<false>{(const void*)(ws + WS_H), (bf16_t*)(ws + WS_X1), (float*)(ws + WS_SSQ1)}, lds);
    xcd_barrier(xb);
    PH(8) gemm_phase((const bf16_t*)(ws + WS_X1), DM, (const bf16_t*)(ws + WS_WGU), DM, MTOK / BM, 2 * DFF / BM, EpiSwiGLU{(bf16_t*)(ws + WS_HID), (const float*)(ws + WS_SSQ1)}, lds);
    xcd_barrier(xb);
    PH(9) { if (threadIdx.x < 256) ((LAS float*)(lds + GEMM_LDS + 256))[threadIdx.x] = 0.f; __syncthreads();
            gemm_phase((const bf16_t*)(ws + WS_HID), DFF, (const bf16_t*)(ws + WS_WDN), DFF, MTOK / BM, DM / BM, EpiFinal{(const bf16_t*)(ws + WS_X1), p.out, (float*)(ws + WS_XST), p.final_norm_g, lds}, lds); }
}

extern "C" void kernel_launch(void* const* d_in, const int* in_sizes, int n_in, void* d_out, int out_size, void* d_ws, size_t ws_size, hipStream_t stream) {
    static int grid_blocks = 0;
    if (grid_blocks == 0) {
        if (n_in != 16 || in_sizes[0] != MTOK * DM || out_size != MTOK * DM || ws_size < WS_TOTAL) { fprintf(stderr, "kernel_launch: shape mismatch (n_in %d, ws %zu)\n", n_in, ws_size); grid_blocks = -1; return; }
        int dev = 0, cus = 0, per_cu = 0;
        hipGetDevice(&dev); hipDeviceGetAttribute(&cus, hipDeviceAttributeMultiprocessorCount, dev);
        if (hipFuncSetAttribute((const void*)mega_fwd, hipFuncAttributeMaxDynamicSharedMemorySize, LDS_BYTES) != hipSuccess) { fprintf(stderr, "hipFuncSetAttribute failed\n"); grid_blocks = -1; return; }
        if (hipOccupancyMaxActiveBlocksPerMultiprocessor(&per_cu, (const void*)mega_fwd, 512, LDS_BYTES) != hipSuccess || per_cu < 1) { fprintf(stderr, "occupancy query: %d\n", per_cu); per_cu = 1; }
        (void)hipGetLastError();
        grid_blocks = cus < 256 ? cus : 256;
    }
    if (grid_blocks < 0) return;
    Params p{};
    p.x = (const float*)d_in[0]; p.norm1_g = (const float*)d_in[1]; p.w_in = (const float*)d_in[2]; p.lb_logits = (const float*)d_in[3]; p.hgrn_norm_g = (const float*)d_in[4];
    p.q_a_norm_g = (const float*)d_in[5]; p.w_q_b = (const float*)d_in[6]; p.kv_a_norm_g = (const float*)d_in[7]; p.w_kv_b = (const float*)d_in[8]; p.mla_norm_g = (const float*)d_in[9];
    p.w_out = (const float*)d_in[10]; p.norm2_g = (const float*)d_in[11]; p.w_gate = (const float*)d_in[12]; p.w_up = (const float*)d_in[13]; p.w_down = (const float*)d_in[14]; p.final_norm_g = (const float*)d_in[15];
    p.out = (float*)d_out; p.ws = (unsigned char*)d_ws;
    if (hipMemsetAsync((char*)d_ws + WS_BAR, 0, XCD_BAR_WORDS * 4, stream) != hipSuccess) { fprintf(stderr, "memset of barrier words failed\n"); return; }
    void* args[] = {&p};
    hipError_t e = hipLaunchCooperativeKernel((const void*)mega_fwd, dim3(grid_blocks), dim3(512), args, LDS_BYTES, stream);
    if (e != hipSuccess) fprintf(stderr, "cooperative launch failed: %s (grid %d)\n", hipGetErrorString(e), grid_blocks);
}
```

```cpp
#include <hip/hip_runtime.h>
#include <hip/hip_cooperative_groups.h>
#include <cstdio>
#include <cstdint>
namespace cg = cooperative_groups;

typedef unsigned short bf16_t;
using bf16x8 = __attribute__((ext_vector_type(8))) short;
using s16x4  = __attribute__((ext_vector_type(4))) short;
using f32x4  = __attribute__((ext_vector_type(4))) float;
using f32x8  = __attribute__((ext_vector_type(8))) float;
using f32x16 = __attribute__((ext_vector_type(16))) float;
using u32x4  = __attribute__((ext_vector_type(4))) unsigned;
using u32x2  = __attribute__((ext_vector_type(2))) unsigned;
#define LAS __attribute__((address_space(3)))
#define DI __device__ __forceinline__

constexpr int MTOK = 65536, DM = 1024, SEQ = 4096, NBATCH = 16;
constexpr int DIN = 3264, DINP = 3328, DFF = 2816;
constexpr int QLORA = 384, KVLORA = 256, QW = 768, KVW = 1024;
constexpr float EPS = 1e-6f;
constexpr int C_HQ = 0, C_HI = 512, C_HF = 1024, C_HG = 2048, C_CQ = 2560, C_CKV = 2944, C_KR = 3200;

constexpr size_t WS_WIN  = 0;
constexpr size_t WS_WQB  = WS_WIN  + (size_t)DINP * DM * 2;
constexpr size_t WS_WKVB = WS_WQB  + (size_t)QW * QLORA * 2;
constexpr size_t WS_WOUT = WS_WKVB + (size_t)KVW * KVLORA * 2;
constexpr size_t WS_WGU  = WS_WOUT + (size_t)DM * DM * 2;
constexpr size_t WS_WDN  = WS_WGU  + (size_t)2 * DFF * DM * 2;
constexpr size_t WS_COS  = WS_WDN  + (size_t)DM * DFF * 2;
constexpr size_t WS_SIN  = WS_COS  + (size_t)SEQ * 32 * 4;
constexpr size_t WS_H    = WS_SIN  + (size_t)SEQ * 32 * 4;
constexpr size_t WS_PROJ = WS_H    + (size_t)MTOK * DM * 2;
constexpr size_t WS_HID  = WS_PROJ;
constexpr size_t WS_R2   = WS_PROJ + (size_t)MTOK * DINP * 2;
constexpr size_t WS_CQN  = WS_R2;
constexpr size_t WS_CKVN = WS_CQN  + (size_t)MTOK * QLORA * 2;
constexpr size_t WS_KR   = WS_CKVN + (size_t)MTOK * KVLORA * 2;
constexpr size_t WS_QB   = WS_KR   + (size_t)MTOK * 64 * 2;
constexpr size_t WS_KV   = WS_QB   + (size_t)MTOK * QW * 2;
constexpr size_t WS_END  = WS_KV   + (size_t)MTOK * KVW * 2;
constexpr size_t WS_OA   = WS_CQN;
constexpr size_t WS_X1   = WS_R2;
constexpr size_t WS_X2   = WS_H;
constexpr size_t WS_SSQ1 = WS_END + 16384;
constexpr size_t WS_SSQ2 = WS_SSQ1 + (size_t)MTOK * 4;
constexpr size_t WS_SSQQ = WS_SSQ2 + (size_t)MTOK * 4;
constexpr size_t WS_SSQKV = WS_SSQQ + (size_t)MTOK * 4;
constexpr size_t WS_OML = WS_SSQKV + (size_t)MTOK * 4;
constexpr size_t WS_XST = WS_OML + 2 * 512 * 4;
constexpr size_t WS_SSQ0 = WS_XST + (size_t)MTOK * 4 * 4;
constexpr size_t WS_TOTAL = WS_SSQ0 + (size_t)MTOK * 4;
static_assert(WS_TOTAL <= (size_t)1 << 30, "workspace total");
static_assert((size_t)MTOK * 512 * 2 <= (size_t)MTOK * (QLORA + KVLORA) * 2, "OA overlay");
static_assert((size_t)MTOK * DM * 4 <= WS_END - WS_R2, "X1 overlay");
static_assert(WS_END <= (size_t)1 << 30, "workspace");

struct Params {
    const float* x; const float* norm1_g; const float* w_in; const float* lb_logits; const float* hgrn_norm_g;
    const float* q_a_norm_g; const float* w_q_b; const float* kv_a_norm_g; const float* w_kv_b; const float* mla_norm_g;
    const float* w_out; const float* norm2_g; const float* w_gate; const float* w_up; const float* w_down; const float* final_norm_g;
    float* out; unsigned char* ws;
};

DI float bf2f(short u) { return __uint_as_float(((unsigned)(unsigned short)u) << 16); }
typedef __bf16 bf16x2_t __attribute__((ext_vector_type(2)));
typedef float f32x2_t __attribute__((ext_vector_type(2)));
DI unsigned cvtpk(float lo, float hi) { f32x2_t v = {lo, hi}; bf16x2_t b = __builtin_convertvector(v, bf16x2_t); return __builtin_bit_cast(unsigned, b); }
DI bf16x8 pack8(const float* v) { u32x4 w = {cvtpk(v[0], v[1]), cvtpk(v[2], v[3]), cvtpk(v[4], v[5]), cvtpk(v[6], v[7])}; return __builtin_bit_cast(bf16x8, w); }
DI float wave_sum(float v) {
#pragma unroll
    for (int o = 32; o > 0; o >>= 1) v += __shfl_xor(v, o);
    return v;
}
DI int opaque_tid() { int t = threadIdx.x; asm volatile("" : "+v"(t)); return t; }
DI int fresh_gw() { return (int)blockIdx.x * 8 + (opaque_tid() >> 6); }
DI int perm32(int rho) { const int n = rho >> 4, i = rho & 15; return 8 * (i >> 2) + 4 * n + (i & 3); }

constexpr int BM = 256, BK = 64, HALF = 128, HT = HALF * BK, GEMM_LDS = 8 * HT * 2, NXCD = 8, WGM = 8;
DI int lds_byte(int r, int c) { int st = (r >> 4) * 2 + (c >> 5), rr = r & 15, cc = c & 31, ob = rr * 64 + cc * 2; return st * 1024 + (ob ^ (((ob >> 9) & 1) << 5)); }
DI void stage_rc(int b, int& R, int& C) { int st = b / 1024, sb = b % 1024, swz = sb ^ (((sb >> 9) & 1) << 5); R = (st >> 1) * 16 + swz / 64; C = (st & 1) * 32 + (swz % 64) / 2; }

template <class Epi>
DI void gemm_unit(const bf16_t* __restrict__ A, long lda, const bf16_t* __restrict__ Bt, int K, int pm, int pn, const Epi& epi, LAS char* shmc) {
    LAS bf16_t* shm = (LAS bf16_t*)shmc;
    const int tidx = opaque_tid();
#define SA(b, h) (shm + ((b) * 2 + (h)) * HT)
#define SB(b, h) (shm + (4 + (b) * 2 + (h)) * HT)
#define STAGE(P, BASE, LD, br, kt, OFF) do { const char* _ub = (const char*)((BASE) + (long)(br) * (LD) + (long)(kt) * BK); \
    _Pragma("unroll") for (int _i = 0; _i < 2; ++_i) { \
      __builtin_amdgcn_global_load_lds((const unsigned*)(_ub + OFF[_i]), (LAS unsigned*)((LAS char*)(P) + tidx * 16 + _i * 8192), 16, 0, 0); } } while (0)
#define LDA(dst, b, h) _Pragma("unroll") for (int m = 0; m < 4; ++m) _Pragma("unroll") for (int k = 0; k < 2; ++k) \
    dst[m][k] = *reinterpret_cast<const LAS bf16x8*>((LAS char*)SA(b, h) + lds_byte(wr * 64 + m * 16 + fr, k * 32 + fq * 8))
#define LDB(dst, b, h) _Pragma("unroll") for (int n = 0; n < 2; ++n) _Pragma("unroll") for (int k = 0; k < 2; ++k) \
    dst[n][k] = *reinterpret_cast<const LAS bf16x8*>((LAS char*)SB(b, h) + lds_byte(wc * 32 + n * 16 + fr, k * 32 + fq * 8))
#define MMA(ai, bj, At, Bt_) do { __builtin_amdgcn_s_setprio(1); \
    _Pragma("unroll") for (int m = 0; m < 4; ++m) _Pragma("unroll") for (int n = 0; n < 2; ++n) _Pragma("unroll") for (int k = 0; k < 2; ++k) \
      acc[ai][bj][m][n] = __builtin_amdgcn_mfma_f32_16x16x32_bf16(Bt_[n][k], At[m][k], acc[ai][bj][m][n], 0, 0, 0); \
    __builtin_amdgcn_s_setprio(0); } while (0)
#define WAIT_V(n) asm volatile("s_waitcnt vmcnt(" #n ")" ::: "memory")
#define WAIT_L(n) asm volatile("s_waitcnt lgkmcnt(" #n ")" ::: "memory")
#define BAR __builtin_amdgcn_s_barrier()
#define SCHED __builtin_amdgcn_sched_barrier(0)
    const int brow = pm * BM, bcol = pn * BM;
    const int wid = tidx >> 6, lane = tidx & 63, wr = wid >> 2, wc = wid & 3, fr = lane & 15, fq = lane >> 4;
    f32x4 acc[2][2][4][2] = {};
    bf16x8 At[4][2], B0[2][2], B1[2][2];
    const int nt = K / BK;
    unsigned offA[2], offB[2];
#pragma unroll
    for (int _i = 0; _i < 2; ++_i) { int _r, _c; stage_rc(tidx * 16 + _i * 8192, _r, _c); offA[_i] = (unsigned)(_r * (int)lda + _c) * 2u; offB[_i] = (unsigned)(_r * K + _c) * 2u; }
    STAGE(SB(0, 0), Bt, K, bcol, 0, offB); STAGE(SA(0, 0), A, lda, brow, 0, offA);
    STAGE(SB(0, 1), Bt, K, bcol + HALF, 0, offB); STAGE(SA(0, 1), A, lda, brow + HALF, 0, offA);
    if (wr == 1) BAR;
    WAIT_V(4); BAR;
    STAGE(SB(1, 0), Bt, K, bcol, 1, offB); STAGE(SA(1, 0), A, lda, brow, 1, offA); STAGE(SB(1, 1), Bt, K, bcol + HALF, 1, offB);
    WAIT_V(6); BAR;
#pragma unroll 1
    for (int t = 0; t < nt - 2; t += 2) {
        LDB(B0, 0, 0); SCHED; LDA(At, 0, 0); STAGE(SA(1, 1), A, lda, brow + HALF, t + 1, offA);
        WAIT_L(8); BAR; WAIT_L(0); MMA(0, 0, At, B0); BAR; SCHED;
        LDB(B1, 0, 1); STAGE(SB(0, 0), Bt, K, bcol, t + 2, offB);
        BAR; WAIT_L(0); MMA(0, 1, At, B1); BAR;
        LDA(At, 0, 1); STAGE(SA(0, 0), A, lda, brow, t + 2, offA);
        BAR; WAIT_L(0); MMA(1, 0, At, B0); BAR; SCHED;
        STAGE(SB(0, 1), Bt, K, bcol + HALF, t + 2, offB);
        WAIT_V(6); BAR; MMA(1, 1, At, B1); BAR;
        LDB(B0, 1, 0); SCHED; LDA(At, 1, 0); STAGE(SA(0, 1), A, lda, brow + HALF, t + 2, offA);
        WAIT_L(8); BAR; WAIT_L(0); MMA(0, 0, At, B0); BAR; SCHED;
        LDB(B1, 1, 1); STAGE(SB(1, 0), Bt, K, bcol, t + 3, offB);
        BAR; WAIT_L(0); MMA(0, 1, At, B1); BAR;
        LDA(At, 1, 1); STAGE(SA(1, 0), A, lda, brow, t + 3, offA);
        BAR; WAIT_L(0); MMA(1, 0, At, B0); BAR; SCHED;
        STAGE(SB(1, 1), Bt, K, bcol + HALF, t + 3, offB);
        WAIT_V(6); BAR; MMA(1, 1, At, B1); BAR;
    }
    { LDB(B0, 0, 0); LDA(At, 0, 0); STAGE(SA(1, 1), A, lda, brow + HALF, nt - 1, offA);
      BAR; WAIT_L(0); MMA(0, 0, At, B0); BAR;
      LDB(B1, 0, 1); BAR; WAIT_L(0); MMA(0, 1, At, B1); BAR;
      LDA(At, 0, 1); WAIT_V(4); BAR; WAIT_L(0); MMA(1, 0, At, B0); MMA(1, 1, At, B1); BAR; }
    { LDB(B0, 1, 0); LDA(At, 1, 0); WAIT_V(2); BAR; WAIT_L(0); MMA(0, 0, At, B0); BAR;
      LDB(B1, 1, 1); WAIT_V(0); BAR; WAIT_L(0); MMA(0, 1, At, B1); BAR;
      LDA(At, 1, 1); BAR; WAIT_L(0); MMA(1, 0, At, B0); MMA(1, 1, At, B1); BAR; }
    if (wr == 0) BAR;
    epi(acc, pm, pn, wr, wc, fr, fq);
#undef SA
#undef SB
#undef STAGE
#undef LDA
#undef LDB
#undef MMA
}

DI bool unit_order(int L, int nM, int nN, int& pm, int& pn) {
    const int nwg = nM * nN; if (L >= nwg) return false;
    int wgid = L; { const int q = nwg / NXCD, r = nwg % NXCD, xcd = wgid % NXCD, off = wgid / NXCD; wgid = (xcd < r ? xcd * (q + 1) : r * (q + 1) + (xcd - r) * q) + off; }
    const int nig = WGM * nN, gid = wgid / nig, fm = gid * WGM, gsz = (nM - fm) < WGM ? (nM - fm) : WGM;
    pm = fm + ((wgid % nig) % gsz); pn = (wgid % nig) / gsz; return true;
}
template <class Epi>
DI void gemm_phase(const bf16_t* A, long lda, const bf16_t* Bt, int K, int nM, int nN, const Epi& epi, LAS char* lds) {
    for (int i = 0;; ++i) { int pm, pn; if (!unit_order(i * (int)gridDim.x + (int)blockIdx.x, nM, nN, pm, pn)) break; gemm_unit(A, lda, Bt, K, pm, pn, epi, lds); }
}

template <bool NT>
struct EpiBf16 {
    bf16_t* O; long ldc;
    DI void operator()(const f32x4 (&acc)[2][2][4][2], int pm, int pn, int wr, int wc, int fr, int fq) const {
#pragma unroll
        for (int ai = 0; ai < 2; ++ai)
#pragma unroll
            for (int m = 0; m < 4; ++m) { bf16_t* rowp = O + (long)(pm * BM + ai * HALF + wr * 64 + m * 16 + fr) * ldc + pn * BM + wc * 32 + 8 * fq;
#pragma unroll
                for (int bj = 0; bj < 2; ++bj) { const f32x4 v0 = acc[ai][bj][m][0], v1 = acc[ai][bj][m][1];
                    u32x4 w = {cvtpk(v0[0], v0[1]), cvtpk(v0[2], v0[3]), cvtpk(v1[0], v1[1]), cvtpk(v1[2], v1[3])};
                    if (NT) __builtin_nontemporal_store(w, (u32x4*)(rowp + bj * HALF)); else *(u32x4*)(rowp + bj * HALF) = w; } }
    }
};
struct EpiProj {
    bf16_t* O; float* ssq_q; float* ssq_kv; const float* oml; const float* ssq0;
    DI void operator()(const f32x4 (&acc)[2][2][4][2], int pm, int pn, int wr, int wc, int fr, int fq) const {
#pragma unroll
        for (int ai = 0; ai < 2; ++ai)
#pragma unroll
            for (int m = 0; m < 4; ++m) { const int row = pm * BM + ai * HALF + wr * 64 + m * 16 + fr; bf16_t* rowp = O + (long)row * DINP + pn * BM + wc * 32 + 8 * fq;
                float s[2];
                const float rs1 = rsqrtf(ssq0[row] * (1.f / DM) + EPS);
#pragma unroll
                for (int bj = 0; bj < 2; ++bj) { f32x4 v0 = acc[ai][bj][m][0] * rs1, v1 = acc[ai][bj][m][1] * rs1;
                    s[bj] = v0[0] * v0[0] + v0[1] * v0[1] + v0[2] * v0[2] + v0[3] * v0[3] + v1[0] * v1[0] + v1[1] * v1[1] + v1[2] * v1[2] + v1[3] * v1[3];
                    const int cat = (2 * pn + bj) >> 2;
                    if (cat == 0 || cat == 4) {
#pragma unroll
                        for (int j = 0; j < 4; ++j) { v0[j] = v0[j] * __builtin_amdgcn_rcpf(1.f + __expf(-v0[j])); v1[j] = v1[j] * __builtin_amdgcn_rcpf(1.f + __expf(-v1[j])); }
                    } else if (cat == 2 || cat == 3) {
                        const float* op = oml + (cat - 2) * 512 + (pn * BM + bj * HALF - cat * 512) + wc * 32 + 8 * fq;
                        const f32x4 m0 = *(const f32x4*)op, m1 = *(const f32x4*)(op + 4);
#pragma unroll
                        for (int j = 0; j < 4; ++j) { v0[j] = m0[j] * __builtin_amdgcn_rcpf(1.f + __expf(fminf(v0[j], 80.f))); v1[j] = m1[j] * __builtin_amdgcn_rcpf(1.f + __expf(fminf(v1[j], 80.f))); }
                    }
                    u32x4 w = {cvtpk(v0[0], v0[1]), cvtpk(v0[2], v0[3]), cvtpk(v1[0], v1[1]), cvtpk(v1[2], v1[3])};
                    __builtin_nontemporal_store(w, (u32x4*)(rowp + bj * HALF)); }
                if (pn >= 10) {
                    float sq = pn == 10 ? s[0] + s[1] : (pn == 11 ? s[0] : 0.f), sk = pn == 11 ? s[1] : (pn == 12 ? s[0] : 0.f);
                    sq += __shfl_xor(sq, 16); sq += __shfl_xor(sq, 32); sk += __shfl_xor(sk, 16); sk += __shfl_xor(sk, 32);
                    if (fq == 0) { if (pn <= 11) atomicAdd(ssq_q + row, sq); if (pn >= 11) atomicAdd(ssq_kv + row, sk); } } }
    }
};
struct EpiBf16Scale {
    bf16_t* O; long ldc; const float* ssq; float inv_k;
    DI void operator()(const f32x4 (&acc)[2][2][4][2], int pm, int pn, int wr, int wc, int fr, int fq) const {
#pragma unroll
        for (int ai = 0; ai < 2; ++ai)
#pragma unroll
            for (int m = 0; m < 4; ++m) { const int row = pm * BM + ai * HALF + wr * 64 + m * 16 + fr; bf16_t* rowp = O + (long)row * ldc + pn * BM + wc * 32 + 8 * fq;
                const float rs = rsqrtf(ssq[row] * inv_k + EPS);
#pragma unroll
                for (int bj = 0; bj < 2; ++bj) { const f32x4 v0 = acc[ai][bj][m][0] * rs, v1 = acc[ai][bj][m][1] * rs;
                    u32x4 w = {cvtpk(v0[0], v0[1]), cvtpk(v0[2], v0[3]), cvtpk(v1[0], v1[1]), cvtpk(v1[2], v1[3])};
                    *(u32x4*)(rowp + bj * HALF) = w; }
                asm volatile("" ::: "memory"); }
    }
};
template <bool R_F32>
struct EpiResid {
    const void* R; bf16_t* O; float* ssq;
    DI void operator()(const f32x4 (&acc)[2][2][4][2], int pm, int pn, int wr, int wc, int fr, int fq) const {
#pragma unroll
        for (int ai = 0; ai < 2; ++ai)
#pragma unroll
            for (int m = 0; m < 4; ++m) { const int row = pm * BM + ai * HALF + wr * 64 + m * 16 + fr; const long off = (long)row * DM + pn * BM + wc * 32 + 8 * fq;
                float s = 0.f;
#pragma unroll
                for (int bj = 0; bj < 2; ++bj) {
                    float v[8];
                    if (R_F32) { const f32x4 r0 = *(const f32x4*)((const float*)R + off + bj * HALF), r1 = *(const f32x4*)((const float*)R + off + bj * HALF + 4);
#pragma unroll
                        for (int j = 0; j < 4; ++j) { v[j] = r0[j] + acc[ai][bj][m][0][j]; v[4 + j] = r1[j] + acc[ai][bj][m][1][j]; }
                    } else { const bf16x8 r = *(const bf16x8*)((const bf16_t*)R + off + bj * HALF);
#pragma unroll
                        for (int j = 0; j < 4; ++j) { v[j] = bf2f(r[j]) + acc[ai][bj][m][0][j]; v[4 + j] = bf2f(r[4 + j]) + acc[ai][bj][m][1][j]; } }
#pragma unroll
                    for (int j = 0; j < 8; ++j) s += v[j] * v[j];
                    *(bf16x8*)(O + off + bj * HALF) = pack8(v); }
                s += __shfl_xor(s, 16); s += __shfl_xor(s, 32);
                if (fq == 0) atomicAdd(ssq + row, s); }
    }
};
struct EpiFinal {
    const bf16_t* R; float* out; float* xst; const float* g; LAS char* lds;
    DI void operator()(const f32x4 (&acc)[2][2][4][2], int pm, int pn, int wr, int wc, int fr, int fq) const {
        LAS float* rowss = (LAS float*)(lds + GEMM_LDS + 256); LAS float* rsl = rowss + 256;
#pragma unroll
        for (int ai = 0; ai < 2; ++ai)
#pragma unroll
            for (int m = 0; m < 4; ++m) { const int rl = ai * HALF + wr * 64 + m * 16 + fr; const long off = (long)(pm * BM + rl) * DM + pn * BM + wc * 32 + 8 * fq;
                float s = 0.f;
#pragma unroll
                for (int bj = 0; bj < 2; ++bj) { const bf16x8 r = *(const bf16x8*)(R + off + bj * HALF);
#pragma unroll
                    for (int j = 0; j < 4; ++j) { const float a = bf2f(r[j]) + acc[ai][bj][m][0][j], b = bf2f(r[4 + j]) + acc[ai][bj][m][1][j]; s += a * a + b * b; } }
                s += __shfl_xor(s, 16); s += __shfl_xor(s, 32);
                if (fq == 0) (void)__hip_atomic_fetch_add(rowss + rl, s, __ATOMIC_RELAXED, __HIP_MEMORY_SCOPE_WORKGROUP); }
        __syncthreads();
        const int tid = opaque_tid();
        if (tid < 256) { const float mine = rowss[tid]; rowss[tid] = 0.f;
            float* slot = xst + (long)(pm * BM + tid) * 4;
            __hip_atomic_store(slot + pn, mine, __ATOMIC_RELAXED, __HIP_MEMORY_SCOPE_AGENT);
            float tot = 0.f;
#pragma unroll
            for (int q = 0; q < 4; ++q) { float v = mine;
                if (q != pn) { unsigned sp = 0; v = __hip_atomic_load(slot + q, __ATOMIC_RELAXED, __HIP_MEMORY_SCOPE_AGENT);
                    while (v < 0.f && ++sp < (1u << 22)) { __builtin_amdgcn_s_sleep(1); v = __hip_atomic_load(slot + q, __ATOMIC_RELAXED, __HIP_MEMORY_SCOPE_AGENT); } }
                tot += v; }
            rsl[tid] = rsqrtf(tot * (1.f / DM) + EPS); }
        __syncthreads();
        const float* gp = g + pn * BM + wc * 32 + 8 * fq;
        f32x4 gv[2][2];
#pragma unroll
        for (int bj = 0; bj < 2; ++bj) { gv[bj][0] = *(const f32x4*)(gp + bj * HALF); gv[bj][1] = *(const f32x4*)(gp + bj * HALF + 4); }
#pragma unroll
        for (int ai = 0; ai < 2; ++ai)
#pragma unroll
            for (int m = 0; m < 4; ++m) { const int rl = ai * HALF + wr * 64 + m * 16 + fr; const long off = (long)(pm * BM + rl) * DM + pn * BM + wc * 32 + 8 * fq;
                const float rs = rsl[rl];
#pragma unroll
                for (int bj = 0; bj < 2; ++bj) { const bf16x8 r = *(const bf16x8*)(R + off + bj * HALF);
                    f32x4 a, b;
#pragma unroll
                    for (int j = 0; j < 4; ++j) { a[j] = (bf2f(r[j]) + acc[ai][bj][m][0][j]) * rs * gv[bj][0][j]; b[j] = (bf2f(r[4 + j]) + acc[ai][bj][m][1][j]) * rs * gv[bj][1][j]; }
                    __builtin_nontemporal_store(a, (f32x4*)(out + off + bj * HALF)); __builtin_nontemporal_store(b, (f32x4*)(out + off + bj * HALF + 4)); } }
    }
};
struct EpiSwiGLU {
    bf16_t* O; const float* ssq;
    DI void operator()(const f32x4 (&acc)[2][2][4][2], int pm, int pn, int wr, int wc, int fr, int fq) const {
#pragma unroll
        for (int ai = 0; ai < 2; ++ai)
#pragma unroll
            for (int m = 0; m < 4; ++m) { const int row = pm * BM + ai * HALF + wr * 64 + m * 16 + fr; bf16_t* rowp = O + (long)row * DFF + pn * HALF + wc * 32 + 8 * fq;
                const float rs = rsqrtf(ssq[row] * (1.f / DM) + EPS);
                float h[8];
#pragma unroll
                for (int n = 0; n < 2; ++n)
#pragma unroll
                    for (int j = 0; j < 4; ++j) { const float g = acc[ai][0][m][n][j] * rs, u = acc[ai][1][m][n][j] * rs; h[n * 4 + j] = g * __builtin_amdgcn_rcpf(1.f + __expf(-g)) * u; }
                __builtin_nontemporal_store(pack8(h), (bf16x8*)rowp); }
    }
};

template <class Src, class RowMap>
DI void wt_convert(bf16_t* Wt, int K, int Npad, const Src& src, const RowMap& rowmap, int gw, int nw) {
    const int lane = opaque_tid() & 63, nl = lane & 15, kq = lane >> 4;
    const int nblocks = Npad / 16, items = nblocks * (K / 32);
    for (int it = gw; it < items; it += nw) {
        const int nb = it % nblocks, kb = it / nblocks, n = nb * 16 + nl, k0 = kb * 32 + kq * 8;
        float v[8];
#pragma unroll
        for (int i = 0; i < 8; ++i) v[i] = src(k0 + i, n);
        *(bf16x8*)(Wt + (long)rowmap(n) * K + k0) = pack8(v);
    }
}
template <bool OUT_F32>
DI void rmsnorm_rows(const float* X, const float* g, void* Out, int gw, int nw) {
    constexpr int RB = 4;
    const int lane = opaque_tid() & 63;
    f32x4 gv[4];
#pragma unroll
    for (int i = 0; i < 2; ++i) { gv[2 * i] = *(const f32x4*)(g + lane * 8 + 512 * i); gv[2 * i + 1] = *(const f32x4*)(g + lane * 8 + 512 * i + 4); }
    for (int row0 = gw * RB; row0 < MTOK; row0 += nw * RB) {
        f32x4 v[RB][4];
#pragma unroll
        for (int r = 0; r < RB; ++r) { const float* xr = X + (long)(row0 + r) * DM;
#pragma unroll
            for (int i = 0; i < 2; ++i) { v[r][2 * i] = __builtin_nontemporal_load((const f32x4*)(xr + lane * 8 + 512 * i)); v[r][2 * i + 1] = __builtin_nontemporal_load((const f32x4*)(xr + lane * 8 + 512 * i + 4)); } }
#pragma unroll
        for (int r = 0; r < RB; ++r) {
            float ss = 0.f;
#pragma unroll
            for (int i = 0; i < 4; ++i) ss += v[r][i][0] * v[r][i][0] + v[r][i][1] * v[r][i][1] + v[r][i][2] * v[r][i][2] + v[r][i][3] * v[r][i][3];
            ss = wave_sum(ss);
            const float rs = rsqrtf(ss * (1.f / DM) + EPS);
#pragma unroll
            for (int i = 0; i < 4; ++i) v[r][i] = v[r][i] * rs * gv[i];
            if (OUT_F32) { float* o = (float*)Out + (long)(row0 + r) * DM;
#pragma unroll
                for (int i = 0; i < 2; ++i) { *(f32x4*)(o + lane * 8 + 512 * i) = v[r][2 * i]; *(f32x4*)(o + lane * 8 + 512 * i + 4) = v[r][2 * i + 1]; }
            } else { bf16_t* o = (bf16_t*)Out + (long)(row0 + r) * DM;
#pragma unroll
                for (int i = 0; i < 2; ++i) { u32x4 w = {cvtpk(v[r][2 * i][0], v[r][2 * i][1]), cvtpk(v[r][2 * i][2], v[r][2 * i][3]), cvtpk(v[r][2 * i + 1][0], v[r][2 * i + 1][1]), cvtpk(v[r][2 * i + 1][2], v[r][2 * i + 1][3])};
                    *(u32x4*)(o + lane * 8 + 512 * i) = w; }
            }
        }
    }
}

DI void xcast_rows(const float* X, bf16_t* Out, float* ssq, int gw, int nw) {
    constexpr int RB = 4;
    const int lane = opaque_tid() & 63;
    for (int row0 = gw * RB; row0 < MTOK; row0 += nw * RB) {
        f32x4 v[RB][4];
#pragma unroll
        for (int r = 0; r < RB; ++r) { const float* xr = X + (long)(row0 + r) * DM;
#pragma unroll
            for (int i = 0; i < 2; ++i) { v[r][2 * i] = __builtin_nontemporal_load((const f32x4*)(xr + lane * 8 + 512 * i)); v[r][2 * i + 1] = __builtin_nontemporal_load((const f32x4*)(xr + lane * 8 + 512 * i + 4)); } }
#pragma unroll
        for (int r = 0; r < RB; ++r) {
            float ss = 0.f;
#pragma unroll
            for (int i = 0; i < 4; ++i) ss += v[r][i][0] * v[r][i][0] + v[r][i][1] * v[r][i][1] + v[r][i][2] * v[r][i][2] + v[r][i][3] * v[r][i][3];
            ss = wave_sum(ss);
            if (lane == 0) ssq[row0 + r] = ss;
            bf16_t* o = Out + (long)(row0 + r) * DM;
#pragma unroll
            for (int i = 0; i < 2; ++i) { u32x4 w = {cvtpk(v[r][2 * i][0], v[r][2 * i][1]), cvtpk(v[r][2 * i][2], v[r][2 * i][3]), cvtpk(v[r][2 * i + 1][0], v[r][2 * i + 1][1]), cvtpk(v[r][2 * i + 1][2], v[r][2 * i + 1][3])};
                *(u32x4*)(o + lane * 8 + 512 * i) = w; }
        }
    }
}
DI void phase0(const Params& p, int gw0, int nw0) {
    unsigned char* ws = p.ws;
    const int wib = gw0 & 7, gw = (gw0 >> 3) * 4 + (wib & 3), nw = nw0 >> 1;
    if (wib < 4) { xcast_rows(p.x, (bf16_t*)(ws + WS_H), (float*)(ws + WS_SSQ0), gw, nw); return; }
    { const float* W = p.w_in; const float* g1 = p.norm1_g; wt_convert((bf16_t*)(ws + WS_WIN), DM, DINP, [=](int k, int n) { const int c = (n & ~31) + perm32(n & 31); return c < DIN ? W[(long)k * DIN + c] * g1[k] : 0.f; }, [](int n) { return n; }, gw, nw); }
    { const float* W = p.w_q_b; const float* gq = p.q_a_norm_g; wt_convert((bf16_t*)(ws + WS_WQB), QLORA, QW, [=](int k, int n) { const int c = (n & ~31) + perm32(n & 31); return W[(long)k * QW + c] * gq[k]; }, [](int n) { return n; }, gw, nw); }
    { const float* W = p.w_kv_b; const float* gk = p.kv_a_norm_g; wt_convert((bf16_t*)(ws + WS_WKVB), KVLORA, KVW, [=](int k, int n) { const int c = (n & ~31) + perm32(n & 31); return W[(long)k * KVW + c] * gk[k]; }, [](int n) { return n; }, gw, nw); }
    { const float* W = p.w_out; wt_convert((bf16_t*)(ws + WS_WOUT), DM, DM, [=](int k, int n) { const int c = (n & ~31) + perm32(n & 31); return W[(long)k * DM + c]; }, [](int n) { return n; }, gw, nw); }
    { const float* W = p.w_gate; const float* g2 = p.norm2_g; wt_convert((bf16_t*)(ws + WS_WGU), DM, DFF, [=](int k, int n) { const int c = (n & ~31) + perm32(n & 31); return W[(long)k * DFF + c] * g2[k]; },
                                            [](int n) { return (n >> 7) * 256 + (n & 127); }, gw, nw); }
    { const float* W = p.w_up; const float* g2 = p.norm2_g; wt_convert((bf16_t*)(ws + WS_WGU), DM, DFF, [=](int k, int n) { const int c = (n & ~31) + perm32(n & 31); return W[(long)k * DFF + c] * g2[k]; },
                                          [](int n) { return (n >> 7) * 256 + 128 + (n & 127); }, gw, nw); }
    { const float* W = p.w_down; wt_convert((bf16_t*)(ws + WS_WDN), DFF, DM, [=](int k, int n) { const int c = (n & ~31) + perm32(n & 31); return W[(long)k * DM + c]; }, [](int n) { return n; }, gw, nw); }
    { float* cs = (float*)(ws + WS_COS); float* sn = (float*)(ws + WS_SIN); const int lane = opaque_tid() & 63;
      for (int idx = gw * 64 + lane; idx < SEQ * 32; idx += nw * 64) { const int pos = idx >> 5, i = idx & 31;
          const float inv = 1.0f / powf(10000.0f, (float)(2 * i) / 64.0f); const float ang = (float)pos * inv; float s, c; sincosf(ang, &s, &c); cs[idx] = c; sn[idx] = s; } }
    { float* om = (float*)(ws + WS_OML); const int lane = opaque_tid() & 63; const int idx = gw * 64 + lane;
      if (idx < 1024) { const int dir = idx >> 9, c = idx & 511; const float a0 = p.lb_logits[dir * 1024 + c], a1 = p.lb_logits[dir * 1024 + 512 + c]; om[idx] = 1.f - 1.f / (1.f + expf(a1 - a0)); } }
    { float* xs = (float*)(ws + WS_XST); const int lane = opaque_tid() & 63; for (int idx = gw * 64 + lane; idx < 4 * MTOK; idx += nw * 64) xs[idx] = -1.f; }
    { float* z = (float*)(ws + WS_SSQ1); const int lane = opaque_tid() & 63; for (int idx = gw * 64 + lane; idx < 4 * MTOK; idx += nw * 64) z[idx] = 0.f; }
}
DI void phase_final(const Params& p, int gw, int nw) {
    constexpr int RB = 4;
    const int lane = opaque_tid() & 63;
    const bf16_t* X2 = (const bf16_t*)(p.ws + WS_X2); const float* ssq = (const float*)(p.ws + WS_SSQ2);
    f32x4 gv[4];
#pragma unroll
    for (int i = 0; i < 2; ++i) { gv[2 * i] = *(const f32x4*)(p.final_norm_g + lane * 8 + 512 * i); gv[2 * i + 1] = *(const f32x4*)(p.final_norm_g + lane * 8 + 512 * i + 4); }
    for (int row0 = gw * RB; row0 < MTOK; row0 += nw * RB) {
        bf16x8 v[RB][2]; float rs[RB];
#pragma unroll
        for (int r = 0; r < RB; ++r) { const bf16_t* xr = X2 + (long)(row0 + r) * DM; v[r][0] = *(const bf16x8*)(xr + lane * 8); v[r][1] = *(const bf16x8*)(xr + lane * 8 + 512); rs[r] = rsqrtf(ssq[row0 + r] * (1.f / DM) + EPS); }
#pragma unroll
        for (int r = 0; r < RB; ++r) { float* o = p.out + (long)(row0 + r) * DM;
#pragma unroll
            for (int i = 0; i < 2; ++i) { f32x4 a, b;
#pragma unroll
                for (int j = 0; j < 4; ++j) { a[j] = bf2f(v[r][i][j]) * rs[r] * gv[2 * i][j]; b[j] = bf2f(v[r][i][4 + j]) * rs[r] * gv[2 * i + 1][j]; }
                __builtin_nontemporal_store(a, (f32x4*)(o + lane * 8 + 512 * i)); __builtin_nontemporal_store(b, (f32x4*)(o + lane * 8 + 512 * i + 4)); } }
    }
}

DI void phase_mla_pre(const Params& p, int gw, int nw) {
    unsigned char* ws = p.ws; const int lane = opaque_tid() & 63;
    const bf16_t* proj = (const bf16_t*)(ws + WS_PROJ); bf16_t* cqn = (bf16_t*)(ws + WS_CQN); bf16_t* ckvn = (bf16_t*)(ws + WS_CKVN); bf16_t* kr = (bf16_t*)(ws + WS_KR);
    const float* cs = (const float*)(ws + WS_COS); const float* sn = (const float*)(ws + WS_SIN);
    float gq[8], gk[8];
#pragma unroll
    for (int j = 0; j < 8; ++j) { gq[j] = lane < 48 ? p.q_a_norm_g[lane * 8 + j] : 0.f; gk[j] = lane < 32 ? p.kv_a_norm_g[lane * 8 + j] : 0.f; }
    constexpr int RB = 4;
    for (int row0 = gw * RB; row0 < MTOK; row0 += nw * RB) {
        bf16x8 a[RB], b[RB], x1[RB], x2[RB];
#pragma unroll
        for (int r = 0; r < RB; ++r) { const bf16_t* pr = proj + (long)(row0 + r) * DINP; a[r] = bf16x8{}; b[r] = bf16x8{}; x1[r] = bf16x8{}; x2[r] = bf16x8{};
            if (lane < 48) a[r] = *(const bf16x8*)(pr + C_CQ + lane * 8);
            if (lane < 32) b[r] = *(const bf16x8*)(pr + C_CKV + lane * 8);
            if (lane < 4) { x1[r] = *(const bf16x8*)(pr + C_KR + lane * 8); x2[r] = *(const bf16x8*)(pr + C_KR + 32 + lane * 8); } }
#pragma unroll
        for (int r = 0; r < RB; ++r) { const int row = row0 + r;
            float fa[8], fb[8], sa = 0.f, sb = 0.f;
#pragma unroll
            for (int j = 0; j < 8; ++j) { fa[j] = bf2f(a[r][j]); fb[j] = bf2f(b[r][j]); sa += fa[j] * fa[j]; sb += fb[j] * fb[j]; }
            sa = wave_sum(sa); sb = wave_sum(sb);
            const float ra = rsqrtf(sa * (1.f / QLORA) + EPS), rb = rsqrtf(sb * (1.f / KVLORA) + EPS);
#pragma unroll
            for (int j = 0; j < 8; ++j) { fa[j] *= ra * gq[j]; fb[j] *= rb * gk[j]; }
            if (lane < 48) *(bf16x8*)(cqn + (long)row * QLORA + lane * 8) = pack8(fa);
            if (lane < 32) *(bf16x8*)(ckvn + (long)row * KVLORA + lane * 8) = pack8(fb);
            if (lane < 4) { const int pos = row & (SEQ - 1);
                float o1[8], o2[8];
#pragma unroll
                for (int j = 0; j < 8; ++j) { const float c = cs[pos * 32 + lane * 8 + j], s = sn[pos * 32 + lane * 8 + j], f1 = bf2f(x1[r][j]), f2 = bf2f(x2[r][j]); o1[j] = f1 * c - f2 * s; o2[j] = f1 * s + f2 * c; }
                *(bf16x8*)(kr + (long)row * 64 + lane * 8) = pack8(o1); *(bf16x8*)(kr + (long)row * 64 + 32 + lane * 8) = pack8(o2); }
        }
    }
}

DI void phase_krope(const Params& p, int gw, int nw) {
    unsigned char* ws = p.ws; const int lane = opaque_tid() & 63, rl = lane >> 2, ch = lane & 3;
    const bf16_t* proj = (const bf16_t*)(ws + WS_PROJ); bf16_t* kr = (bf16_t*)(ws + WS_KR);
    const float* cs = (const float*)(ws + WS_COS); const float* sn = (const float*)(ws + WS_SIN);
    for (int row0 = gw * 16; row0 < MTOK; row0 += nw * 16) { const int row = row0 + rl, pos = row & (SEQ - 1);
        const bf16_t* pr = proj + (long)row * DINP + C_KR + ch * 8;
        const bf16x8 x1 = *(const bf16x8*)pr, x2 = *(const bf16x8*)(pr + 32);
        const f32x4 c0 = *(const f32x4*)(cs + pos * 32 + ch * 8), c1 = *(const f32x4*)(cs + pos * 32 + ch * 8 + 4), s0 = *(const f32x4*)(sn + pos * 32 + ch * 8), s1 = *(const f32x4*)(sn + pos * 32 + ch * 8 + 4);
        float o1[8], o2[8];
#pragma unroll
        for (int j = 0; j < 8; ++j) { const float c = j < 4 ? c0[j & 3] : c1[j & 3], s = j < 4 ? s0[j & 3] : s1[j & 3], f1 = bf2f(x1[j]), f2 = bf2f(x2[j]); o1[j] = f1 * c - f2 * s; o2[j] = f1 * s + f2 * c; }
        *(bf16x8*)(kr + (long)row * 64 + ch * 8) = pack8(o1); *(bf16x8*)(kr + (long)row * 64 + 32 + ch * 8) = pack8(o2); }
}

DI void phase_mix_pre(const Params& p, int gw, int nw) {
    unsigned char* ws = p.ws; const int lane = opaque_tid() & 63;
    const bf16_t* proj = (const bf16_t*)(ws + WS_PROJ); const bf16_t* OF = (const bf16_t*)p.out; const bf16_t* OB = OF + (long)MTOK * 512;
    const bf16_t* OA = (const bf16_t*)(ws + WS_OA); bf16_t* Y = (bf16_t*)p.out + (long)MTOK * 1024;
    float gh[8], gm[8];
#pragma unroll
    for (int j = 0; j < 8; ++j) { gh[j] = p.hgrn_norm_g[lane * 8 + j]; gm[j] = p.mla_norm_g[lane * 8 + j]; }
    constexpr int RB = 4;
    for (int row0 = gw * RB; row0 < MTOK; row0 += nw * RB) {
        bf16x8 of[RB], ob[RB], hg[RB], oa[RB];
#pragma unroll
        for (int r = 0; r < RB; ++r) { const long row = row0 + r;
            of[r] = *(const bf16x8*)(OF + row * 512 + lane * 8); ob[r] = *(const bf16x8*)(OB + row * 512 + lane * 8);
            hg[r] = *(const bf16x8*)(proj + row * DINP + C_HG + lane * 8); oa[r] = *(const bf16x8*)(OA + row * 512 + lane * 8); }
#pragma unroll
        for (int r = 0; r < RB; ++r) { const long row = row0 + r;
            float o[8], a[8], so = 0.f, sa = 0.f;
#pragma unroll
            for (int j = 0; j < 8; ++j) { o[j] = bf2f(of[r][j]) + bf2f(ob[r][j]); a[j] = bf2f(oa[r][j]); so += o[j] * o[j]; sa += a[j] * a[j]; }
            so += __shfl_xor(so, 1); so += __shfl_xor(so, 2); so += __shfl_xor(so, 4);
            sa = wave_sum(sa);
            const float ro = rsqrtf(so * (1.f / 64.f) + EPS), ra = rsqrtf(sa * (1.f / 512.f) + EPS);
#pragma unroll
            for (int j = 0; j < 8; ++j) { o[j] = o[j] * ro * gh[j] * bf2f(hg[r][j]);     a[j] = a[j] * ra * gm[j]; }
            *(bf16x8*)(Y + row * DM + lane * 8) = pack8(o); *(bf16x8*)(Y + row * DM + 512 + lane * 8) = pack8(a);
        }
    }
}

constexpr int ATT_SHM_V = 64 * 128 * 2, ATT_SHM_K = 64 * 128 * 2, ATT_SHM_R = 64 * 64 * 2;
constexpr int ATT_OFF_K = 2 * ATT_SHM_V, ATT_OFF_R = ATT_OFF_K + 2 * ATT_SHM_K, ATT_OFF_W = ATT_OFF_R + 2 * ATT_SHM_R, ATT_OFF_Q = ATT_OFF_W + 8 * 64 * 4, ATT_LDS = ATT_OFF_Q + 8 * 4 * 64 * 16;
constexpr float ATT_SCALE = 0.07216878364870322f;
constexpr float ATT_THR = 8.f;
#define KSWZ(row, colB) ((row) * 256 + ((colB) ^ (((row) & 15) << 4)))
#define RSWZ(row, colB) ((row) * 128 + ((colB) ^ ((((row) >> 1) & 7) << 4)))
#define SBAR() __builtin_amdgcn_sched_barrier(0)
DI int crow(int r, int hi) { return (r & 3) + 8 * (r >> 2) + 4 * hi; }

DI void partialSM(f32x16& p0, f32x16& p1, float& m_reg, float& mn, float& alpha) {
    constexpr float C = ATT_SCALE * 1.4426950408889634f;
    float pmax = p0[0];
#pragma unroll
    for (int r = 1; r < 16; ++r) pmax = fmaxf(pmax, p0[r]);
#pragma unroll
    for (int r = 0; r < 16; ++r) pmax = fmaxf(pmax, p1[r]);
    { auto rr = __builtin_amdgcn_permlane32_swap(__float_as_uint(pmax), __float_as_uint(pmax), false, false);
      pmax = fmaxf(__uint_as_float(rr[0]), __uint_as_float(rr[1])); }
    if (__builtin_expect(__all(pmax - m_reg <= ATT_THR / ATT_SCALE), 1)) { mn = m_reg; alpha = 1.f; }
    else { mn = fmaxf(m_reg, pmax); alpha = __builtin_amdgcn_exp2f((m_reg - mn) * C); m_reg = mn; }
    const float mnC = -mn * C;
#pragma unroll
    for (int r = 0; r < 16; ++r) p0[r] = fmaf(p0[r], C, mnC);
#pragma unroll
    for (int r = 0; r < 16; ++r) p1[r] = fmaf(p1[r], C, mnC);
#pragma unroll
    for (int r = 0; r < 16; ++r) p0[r] = __builtin_amdgcn_exp2f(p0[r]);
}
DI void finishSM(f32x16& p0, f32x16& p1, float alpha, float& l_reg, bf16x8& pa0, bf16x8& pa1, bf16x8& pa2, bf16x8& pa3) {
#pragma unroll
    for (int r = 0; r < 16; ++r) p1[r] = __builtin_amdgcn_exp2f(p1[r]);
    float ps = 0;
#pragma unroll
    for (int r = 0; r < 16; ++r) ps += p0[r];
#pragma unroll
    for (int r = 0; r < 16; ++r) ps += p1[r];
    { auto rr = __builtin_amdgcn_permlane32_swap(__float_as_uint(ps), __float_as_uint(ps), false, false);
      ps = __uint_as_float(rr[0]) + __uint_as_float(rr[1]); }
    l_reg = l_reg * alpha + ps;
#define PK4(P, BASE, OUT) do { unsigned a0 = cvtpk(P[BASE + 0], P[BASE + 1]), a1 = cvtpk(P[BASE + 2], P[BASE + 3]);   \
    unsigned b0 = cvtpk(P[BASE + 4], P[BASE + 5]), b1 = cvtpk(P[BASE + 6], P[BASE + 7]);                              \
    auto r0 = __builtin_amdgcn_permlane32_swap(a0, b0, false, false); auto r1 = __builtin_amdgcn_permlane32_swap(a1, b1, false, false); \
    u32x4 w = {r0[0], r1[0], r0[1], r1[1]}; OUT = __builtin_bit_cast(bf16x8, w); } while (0)
    PK4(p0, 0, pa0); PK4(p0, 8, pa1); PK4(p1, 0, pa2); PK4(p1, 8, pa3);
#undef PK4
}
DI void qkt(f32x16& p0, f32x16& p1, const LAS char* Ks, const LAS char* Rs, const bf16x8* qr, const LAS bf16x8* qrl, int r32, int hi) {
    p0 = f32x16{}; p1 = f32x16{};
    __builtin_amdgcn_s_setprio(1);
#pragma unroll
    for (int d0 = 0; d0 < 8; ++d0) { const int cb = (d0 * 16 + hi * 8) * 2;
        const bf16x8 b0 = *reinterpret_cast<const LAS bf16x8*>(Ks + KSWZ(r32, cb));
        const bf16x8 b1 = *reinterpret_cast<const LAS bf16x8*>(Ks + KSWZ(32 + r32, cb));
        p0 = __builtin_amdgcn_mfma_f32_32x32x16_bf16(b0, qr[d0], p0, 0, 0, 0);
        p1 = __builtin_amdgcn_mfma_f32_32x32x16_bf16(b1, qr[d0], p1, 0, 0, 0); }
#pragma unroll
    for (int d0 = 0; d0 < 4; ++d0) { const int cb = (d0 * 16 + hi * 8) * 2;
        const bf16x8 b0 = *reinterpret_cast<const LAS bf16x8*>(Rs + RSWZ(r32, cb));
        const bf16x8 b1 = *reinterpret_cast<const LAS bf16x8*>(Rs + RSWZ(32 + r32, cb));
        const bf16x8 qv = qrl[d0 * 64];
        p0 = __builtin_amdgcn_mfma_f32_32x32x16_bf16(b0, qv, p0, 0, 0, 0);
        p1 = __builtin_amdgcn_mfma_f32_32x32x16_bf16(b1, qv, p1, 0, 0, 0); }
    __builtin_amdgcn_s_setprio(0);
}
DI int v_st(int k, int c) { const int kk = (k & ~0xC) | ((k & 4) << 1) | ((k & 8) >> 1); return ((kk >> 3) * 4 + (c >> 5)) * 512 + ((kk & 7) * 32 + (c & 31)) * 2; }
DI int v_rd_base(int lane) { return ((lane & 3) << 3) | (((lane >> 2) & 3) << 6) | (((lane >> 4) & 1) << 5) | (((lane >> 5) & 1) << 8); }
constexpr int v_rd_off(int d0, int ks, int half) { return d0 * 512 + ks * 4096 + half * 2048; }
template <int OFF> DI s16x4 tr_read(int vb) { s16x4 r; asm volatile("ds_read_b64_tr_b16 %0, %1 offset:%2" : "=&v"(r) : "v"(vb), "i"(OFF) : "memory"); return r; }
template <int D0> DI void pv_one(f32x16& od, int vb, bf16x8 pa0, bf16x8 pa1, bf16x8 pa2, bf16x8 pa3) {
    const s16x4 l0 = tr_read<v_rd_off(D0, 0, 0)>(vb), h0 = tr_read<v_rd_off(D0, 0, 1)>(vb), l1 = tr_read<v_rd_off(D0, 1, 0)>(vb), h1 = tr_read<v_rd_off(D0, 1, 1)>(vb);
    const s16x4 l2 = tr_read<v_rd_off(D0, 2, 0)>(vb), h2 = tr_read<v_rd_off(D0, 2, 1)>(vb), l3 = tr_read<v_rd_off(D0, 3, 0)>(vb), h3 = tr_read<v_rd_off(D0, 3, 1)>(vb);
    asm volatile("s_waitcnt lgkmcnt(0)" ::: "memory"); SBAR();
#define PK(L, H) (bf16x8){L[0], L[1], L[2], L[3], H[0], H[1], H[2], H[3]}
    od = __builtin_amdgcn_mfma_f32_32x32x16_bf16(pa0, PK(l0, h0), od, 0, 0, 0);
    od = __builtin_amdgcn_mfma_f32_32x32x16_bf16(pa1, PK(l1, h1), od, 0, 0, 0);
    od = __builtin_amdgcn_mfma_f32_32x32x16_bf16(pa2, PK(l2, h2), od, 0, 0, 0);
    od = __builtin_amdgcn_mfma_f32_32x32x16_bf16(pa3, PK(l3, h3), od, 0, 0, 0);
#undef PK
}
DI void pv_d0(f32x16* o, int vb, bf16x8 pa0, bf16x8 pa1, bf16x8 pa2, bf16x8 pa3) {
    pv_one<0>(o[0], vb, pa0, pa1, pa2, pa3); pv_one<1>(o[1], vb, pa0, pa1, pa2, pa3); pv_one<2>(o[2], vb, pa0, pa1, pa2, pa3); pv_one<3>(o[3], vb, pa0, pa1, pa2, pa3);
}

DI void attn_unit(const bf16_t* __restrict__ QB, const bf16_t* __restrict__ KVb, const bf16_t* __restrict__ KRb, const float* __restrict__ cs, const float* __restrict__ sn,
                  bf16_t* __restrict__ OA, int b, int h, int i0, LAS char* lds) {
    const int tid = opaque_tid(), wid = tid >> 6, lane = tid & 63, r32 = lane & 31, hi = lane >> 5;
    LAS char* V_lds = lds; LAS char* K_lds = lds + ATT_OFF_K; LAS char* R_lds = lds + ATT_OFF_R;
    LAS float* wsl = (LAS float*)(lds + ATT_OFF_W) + wid * 64; LAS float* li_l = wsl; LAS float* al_l = wsl + 32;
    float m_reg = -1e30f, l_reg = 0; f32x16 o[4] = {}; bf16x8 qr[8];
    const int pos = i0 + wid * 32 + r32;
    const bf16_t* Qw = QB + ((long)b * SEQ + pos) * QW + h * 192 + hi * 8;
    LAS bf16x8* qrl = (LAS bf16x8*)(lds + ATT_OFF_Q) + wid * 256 + lane;
#pragma unroll
    for (int d0 = 0; d0 < 8; ++d0) qr[d0] = *(const bf16x8*)(Qw + d0 * 16);
#pragma unroll
    for (int a = 0; a < 2; ++a) {
        const bf16x8 x1 = *(const bf16x8*)(Qw + (8 + a) * 16), x2 = *(const bf16x8*)(Qw + (10 + a) * 16);
        const float* cp = cs + pos * 32 + 16 * a + 8 * hi; const float* sp = sn + pos * 32 + 16 * a + 8 * hi;
        float o1[8], o2[8];
#pragma unroll
        for (int j = 0; j < 8; ++j) { const float c = cp[j], s = sp[j], f1 = bf2f(x1[j]), f2 = bf2f(x2[j]); o1[j] = f1 * c - f2 * s; o2[j] = f1 * s + f2 * c; }
        qrl[a * 64] = pack8(o1); qrl[(2 + a) * 64] = pack8(o2);
    }
    const bf16_t* Kh = KVb + (long)b * SEQ * KVW + h * 256; const bf16_t* Vh = Kh + 128; const bf16_t* Rh = KRb + (long)b * SEQ * 64;
    const int sr = tid >> 4, sc = (tid & 15) * 8, vst0 = v_st(sr, sc), vst1 = v_st(32 + sr, sc);
    const int rr = tid >> 3, rc = (tid & 7) * 8;
    const int vb0 = (int)(uintptr_t)V_lds + v_rd_base(lane);
    bf16x8 vs0, vs1, ks0, ks1, rs0;
    const unsigned so0 = (unsigned)(sr * KVW + sc) * 2u, so1 = so0 + 32u * KVW * 2u, sor = (unsigned)(rr * 64 + rc) * 2u;
#define SLOAD(k0) do { const char* _vb = (const char*)(Vh + (long)(k0) * KVW); const char* _rb = (const char*)(Rh + (long)(k0) * 64); \
    vs0 = *(const bf16x8*)(_vb + so0); vs1 = *(const bf16x8*)(_vb + so1); \
    ks0 = *(const bf16x8*)(_vb + so0 - 256); ks1 = *(const bf16x8*)(_vb + so1 - 256); \
    rs0 = *(const bf16x8*)(_rb + sor); } while (0)
#define SWRITE(bi) do { *(LAS bf16x8*)(V_lds + (bi) * ATT_SHM_V + vst0) = vs0; *(LAS bf16x8*)(V_lds + (bi) * ATT_SHM_V + vst1) = vs1; const int kc = sc * 2; \
    *(LAS bf16x8*)(K_lds + (bi) * ATT_SHM_K + KSWZ(sr, kc)) = ks0; *(LAS bf16x8*)(K_lds + (bi) * ATT_SHM_K + KSWZ(32 + sr, kc)) = ks1; \
    *(LAS bf16x8*)(R_lds + (bi) * ATT_SHM_R + RSWZ(rr, rc * 2)) = rs0; } while (0)
#define RESC(a) do { if (__any((a) < 1.f)) { if (hi == 0) al_l[r32] = (a); asm volatile("s_waitcnt lgkmcnt(0)" ::: "memory"); \
    _Pragma("unroll") for (int d = 0; d < 4; ++d) _Pragma("unroll") for (int r = 0; r < 16; ++r) o[d][r] *= al_l[crow(r, hi)]; } } while (0)
    f32x16 pA0, pA1, pB0, pB1; float mnA, mnB, alA, alB; bf16x8 pa0, pa1, pa2, pa3; constexpr int NT = SEQ / 64;
    SLOAD(0); SWRITE(0); __syncthreads();
    qkt(pA0, pA1, K_lds, R_lds, qr, qrl, r32, hi); partialSM(pA0, pA1, m_reg, mnA, alA);
    SLOAD(64); SWRITE(1); __syncthreads();
    for (int j = 1; j + 1 < NT; j += 2) {
        SBAR(); qkt(pB0, pB1, K_lds + ATT_SHM_K, R_lds + ATT_SHM_R, qr, qrl, r32, hi);
        finishSM(pA0, pA1, alA, l_reg, pa0, pa1, pa2, pa3); SBAR();
        SLOAD((j + 1) * 64); SBAR();
        pv_d0(o, vb0, pa0, pa1, pa2, pa3); partialSM(pB0, pB1, m_reg, mnB, alB);
        __syncthreads(); SWRITE(0);
        RESC(alB); __syncthreads();
        SBAR(); qkt(pA0, pA1, K_lds, R_lds, qr, qrl, r32, hi);
        finishSM(pB0, pB1, alB, l_reg, pa0, pa1, pa2, pa3); SBAR();
        SLOAD((j + 2) * 64); SBAR();
        pv_d0(o, vb0 + ATT_SHM_V, pa0, pa1, pa2, pa3); partialSM(pA0, pA1, m_reg, mnA, alA);
        __syncthreads(); SWRITE(1);
        RESC(alA); __syncthreads();
    }
    SBAR(); qkt(pB0, pB1, K_lds + ATT_SHM_K, R_lds + ATT_SHM_R, qr, qrl, r32, hi);
    finishSM(pA0, pA1, alA, l_reg, pa0, pa1, pa2, pa3); SBAR();
    pv_d0(o, vb0, pa0, pa1, pa2, pa3); partialSM(pB0, pB1, m_reg, mnB, alB);
    __syncthreads(); RESC(alB);
    finishSM(pB0, pB1, alB, l_reg, pa0, pa1, pa2, pa3); SBAR();
    pv_d0(o, vb0 + ATT_SHM_V, pa0, pa1, pa2, pa3);
    if (hi == 0) li_l[r32] = l_reg; asm volatile("s_waitcnt lgkmcnt(0)" ::: "memory");
    float rli[16];
#pragma unroll
    for (int r = 0; r < 16; ++r) rli[r] = __builtin_amdgcn_rcpf(li_l[crow(r, hi)]);
    bf16_t* Ow = OA + ((long)b * SEQ + i0 + wid * 32) * 512 + h * 128;
#pragma unroll
    for (int r = 0; r < 16; ++r) { const int orow = crow(r, hi);
#pragma unroll
        for (int d0 = 0; d0 < 4; ++d0) { const float v = o[d0][r] * rli[r]; Ow[(long)orow * 512 + d0 * 32 + r32] = (bf16_t)(cvtpk(v, v) & 0xffffu); } }
#undef SLOAD
#undef SWRITE
#undef RESC
}

constexpr int HG_LD = 80;
constexpr int HG_TILE = 64 * HG_LD * 2;
constexpr int HG_QD = 0, HG_KI = HG_TILE, HG_KET = 2 * HG_TILE, HG_VT = 3 * HG_TILE, HG_PP = 4 * HG_TILE, HG_ST = 5 * HG_TILE, HG_TOT = 6 * HG_TILE, HG_DEC = HG_TOT + 8 * 64 * 4, HG_RAW = ((HG_DEC + 512 + 1023) / 1024) * 1024, HG_LDS = HG_RAW + 3 * 8192;

DI void hgrn_item(const Params& p, int item, LAS char* lds) {
    const int tid = opaque_tid(), lane = tid & 63, wid = tid >> 6, fr = lane & 15, fq = lane >> 4;
    const int dir = item & 1, h = (item >> 1) & 7, b = item >> 4;
    const bf16_t* proj = (const bf16_t*)(p.ws + WS_PROJ) + (long)b * SEQ * DINP;
    bf16_t* O = (bf16_t*)p.out + (long)dir * MTOK * 512 + (long)b * SEQ * 512 + h * 64;
    const int i = lane, dc = wid * 8;
    const int li = tid >> 3, lch = tid & 7;
    const int colq = C_HQ + h * 64 + lch * 8, colv = C_HI + h * 64 + lch * 8, colf = C_HF + dir * 512 + h * 64 + lch * 8;
    LAS char* RAW = lds + HG_RAW;
    const int raw_wr = li * 128 + ((lch ^ ((li >> 1) & 7)) << 4), raw_rd = i * 128 + ((wid ^ ((i >> 1) & 7)) << 4);
    LAS bf16_t* QD = (LAS bf16_t*)(lds + HG_QD); LAS bf16_t* KI = (LAS bf16_t*)(lds + HG_KI); LAS bf16_t* KET = (LAS bf16_t*)(lds + HG_KET);
    LAS bf16_t* VT = (LAS bf16_t*)(lds + HG_VT); LAS bf16_t* PP = (LAS bf16_t*)(lds + HG_PP); LAS bf16_t* ST = (LAS bf16_t*)(lds + HG_ST);
    LAS float* DEC = (LAS float*)(lds + HG_DEC);
    const int tm = wid >> 1, tn0 = (wid & 1) * 2;
    f32x4 S[2] = {};
    __syncthreads();
#pragma unroll
    for (int t = 0; t < 2; ++t) *(LAS u32x2*)(ST + (16 * (tn0 + t) + fr) * HG_LD + 16 * tm + 4 * fq) = (u32x2){0u, 0u};
    bf16x8 rq, rf, rv;
    { const int c = dir ? 63 : 0; const long row = (long)c * 64 + (dir ? 63 - li : li); const bf16_t* pr = proj + row * DINP;
      rq = *(const bf16x8*)(pr + colq); rf = *(const bf16x8*)(pr + colf); rv = *(const bf16x8*)(pr + colv); }
    for (int n = 0; n < 64; ++n) {
        const int c = dir ? 63 - n : n;
        bf16x8 nq = rq, nf = rf, nv = rv;
        if (n + 1 < 64) { const int c2 = dir ? c - 1 : c + 1; const long row = (long)c2 * 64 + (dir ? 63 - li : li); const bf16_t* pr = proj + row * DINP;
            nq = *(const bf16x8*)(pr + colq); nf = *(const bf16x8*)(pr + colf); nv = *(const bf16x8*)(pr + colv); }
        *(LAS bf16x8*)(RAW + raw_wr) = rq; *(LAS bf16x8*)(RAW + 8192 + raw_wr) = rf; *(LAS bf16x8*)(RAW + 16384 + raw_wr) = rv;
        __syncthreads();
        const bf16x8 xq = *(const LAS bf16x8*)(RAW + raw_rd), xf = *(const LAS bf16x8*)(RAW + 8192 + raw_rd), xv = *(const LAS bf16x8*)(RAW + 16384 + raw_rd);
        float P[8], kk[8];
#pragma unroll
        for (int j = 0; j < 8; ++j) { kk[j] = bf2f(xf[j]); P[j] = 1.f - kk[j]; }
#define DPP_MUL(CTRL, RMASK) _Pragma("unroll") for (int j = 0; j < 8; ++j) { \
            const float t = __builtin_bit_cast(float, __builtin_amdgcn_update_dpp(0x3f800000, __builtin_bit_cast(int, P[j]), CTRL, RMASK, 0xF, false)); P[j] *= t; }
        DPP_MUL(0x111, 0xF) DPP_MUL(0x112, 0xF) DPP_MUL(0x114, 0xF) DPP_MUL(0x118, 0xF) DPP_MUL(0x142, 0xA) DPP_MUL(0x143, 0xC)
#undef DPP_MUL
        float qd[8], ki[8];
#pragma unroll
        for (int j = 0; j < 8; ++j) { const float plast = __builtin_bit_cast(float, __builtin_amdgcn_readlane(__builtin_bit_cast(int, P[j]), 63)); const float sq = bf2f(xq[j]);
            const float rp = __builtin_amdgcn_rcpf(P[j]);
            qd[j] = sq * P[j]; ki[j] = kk[j] * rp; const float ke = ki[j] * plast;
            KET[(dc + j) * HG_LD + i] = (bf16_t)(cvtpk(ke, ke) & 0xffffu); VT[(dc + j) * HG_LD + i] = (bf16_t)xv[j];
            if (lane == 0) DEC[(n & 1) * 64 + dc + j] = plast; }
        *(LAS bf16x8*)(QD + i * HG_LD + dc) = pack8(qd); *(LAS bf16x8*)(KI + i * HG_LD + dc) = pack8(ki);
        __syncthreads();
        bf16x8 QDf[2], KETf[2], KIf[2][2], VTf[2][2], STf[2][2];
#pragma unroll
        for (int ks = 0; ks < 2; ++ks) {
            QDf[ks] = *(const LAS bf16x8*)(QD + (16 * tm + fr) * HG_LD + 32 * ks + 8 * fq);
            KETf[ks] = *(const LAS bf16x8*)(KET + (16 * tm + fr) * HG_LD + 32 * ks + 8 * fq);
#pragma unroll
            for (int t = 0; t < 2; ++t) { const int rw = (16 * (tn0 + t) + fr) * HG_LD + 32 * ks + 8 * fq;
                KIf[t][ks] = *(const LAS bf16x8*)(KI + rw); VTf[t][ks] = *(const LAS bf16x8*)(VT + rw); STf[t][ks] = *(const LAS bf16x8*)(ST + rw); } }
        f32x4 sc[2] = {}, u[2] = {}, oT[2] = {};
#pragma unroll
        for (int t = 0; t < 2; ++t)
#pragma unroll
            for (int ks = 0; ks < 2; ++ks) {
                sc[t] = __builtin_amdgcn_mfma_f32_16x16x32_bf16(KIf[t][ks], QDf[ks], sc[t], 0, 0, 0);
                u[t]  = __builtin_amdgcn_mfma_f32_16x16x32_bf16(KETf[ks], VTf[t][ks], u[t], 0, 0, 0);
                oT[t] = __builtin_amdgcn_mfma_f32_16x16x32_bf16(STf[t][ks], QDf[ks], oT[t], 0, 0, 0);
            }
#pragma unroll
        for (int t = 0; t < 2; ++t) { const int ii = 16 * tm + fr, j0 = 16 * (tn0 + t) + 4 * fq;
            float m[4];
#pragma unroll
            for (int r = 0; r < 4; ++r) m[r] = (j0 + r <= ii) ? sc[t][r] : 0.f;
            *(LAS u32x2*)(PP + ii * HG_LD + j0) = (u32x2){cvtpk(m[0], m[1]), cvtpk(m[2], m[3])}; }
        __syncthreads();
        bf16x8 PPf[2];
#pragma unroll
        for (int ks = 0; ks < 2; ++ks) PPf[ks] = *(const LAS bf16x8*)(PP + (16 * tm + fr) * HG_LD + 32 * ks + 8 * fq);
#pragma unroll
        for (int t = 0; t < 2; ++t)
#pragma unroll
            for (int ks = 0; ks < 2; ++ks) oT[t] = __builtin_amdgcn_mfma_f32_16x16x32_bf16(VTf[t][ks], PPf[ks], oT[t], 0, 0, 0);
        { const long orow = (long)c * 64 + (dir ? 63 - (16 * tm + fr) : (16 * tm + fr));
#pragma unroll
          for (int t = 0; t < 2; ++t) *(u32x2*)(O + orow * 512 + 16 * (tn0 + t) + 4 * fq) = (u32x2){cvtpk(oT[t][0], oT[t][1]), cvtpk(oT[t][2], oT[t][3])}; }
        const f32x4 dcy = *(const LAS f32x4*)(DEC + (n & 1) * 64 + 16 * tm + 4 * fq);
#pragma unroll
        for (int t = 0; t < 2; ++t) { S[t] = dcy * S[t] + u[t];
            *(LAS u32x2*)(ST + (16 * (tn0 + t) + fr) * HG_LD + 16 * tm + 4 * fq) = (u32x2){cvtpk(S[t][0], S[t][1]), cvtpk(S[t][2], S[t][3])}; }
        rq = nq; rf = nf; rv = nv;
    }
}

DI void hgrn_item_naive(const Params& p, int item, LAS char* lds) {
    const int tid = threadIdx.x; const int d = tid >> 3, e0 = (tid & 7) * 8;
    const int dir = item & 1, h = (item >> 1) & 7, b = item >> 4;
    const bf16_t* proj = (const bf16_t*)(p.ws + WS_PROJ) + (long)b * SEQ * DINP;
    bf16_t* O = (bf16_t*)p.out + (long)dir * MTOK * 512 + (long)b * SEQ * 512 + h * 64;
    const float a0 = p.lb_logits[dir * 1024 + h * 64 + d], a1 = p.lb_logits[dir * 1024 + 512 + h * 64 + d];
    const float lb = 1.f / (1.f + expf(a1 - a0));
    float S[8] = {0, 0, 0, 0, 0, 0, 0, 0};
    LAS float* part = (LAS float*)lds;
    __syncthreads();
    for (int n = 0; n < SEQ; ++n) {
        const int t = dir ? SEQ - 1 - n : n;
        const bf16_t* pr = proj + (long)t * DINP;
        const float z = bf2f((short)pr[C_HF + dir * 512 + h * 64 + d]); const float sig = 1.f / (1.f + expf(-z));
        const float f = lb + (1.f - lb) * sig; const float k = (1.f - lb) * (1.f / (1.f + expf(z)));
        float q = bf2f((short)pr[C_HQ + h * 64 + d]); q = q / (1.f + expf(-q));
        const bf16x8 vv = *(const bf16x8*)(pr + C_HI + h * 64 + e0);
#pragma unroll
        for (int j = 0; j < 8; ++j) { const float v = bf2f(vv[j]); S[j] = f * S[j] + k * v; part[d * 64 + e0 + j] = S[j] * q; }
        __syncthreads();
        if (tid < 64) { float o = 0.f;
#pragma unroll 8
            for (int dd = 0; dd < 64; ++dd) o += part[dd * 64 + tid];
            O[(long)t * 512 + tid] = (bf16_t)(cvtpk(o, o) & 0xffffu); }
        __syncthreads();
    }
}

DI void dbg_hgrn(const Params& p, LAS char* lds, int dir, unsigned* flag, unsigned bit) {
    const int tid = threadIdx.x; const int d = tid >> 3, e0 = (tid & 7) * 8;
    const int b = 1, h = 3;
    const bf16_t* proj = (const bf16_t*)(p.ws + WS_PROJ) + (long)b * SEQ * DINP;
    const bf16_t* O = (const bf16_t*)p.out + (long)dir * MTOK * 512 + (long)b * SEQ * 512 + h * 64;
    const float a0 = p.lb_logits[dir * 1024 + h * 64 + d], a1 = p.lb_logits[dir * 1024 + 512 + h * 64 + d];
    const float lb = 1.f / (1.f + expf(a1 - a0));
    float S[8] = {0, 0, 0, 0, 0, 0, 0, 0};
    LAS float* part = (LAS float*)lds;
    float maxdiff = 0.f, maxref = 0.f;
    __syncthreads();
    for (int n = 0; n < 512; ++n) {
        const int t = dir ? SEQ - 1 - n : n;
        const bf16_t* pr = proj + (long)t * DINP;
        const float z = bf2f((short)pr[C_HF + dir * 512 + h * 64 + d]); const float sig = 1.f / (1.f + expf(-z));
        const float f = lb + (1.f - lb) * sig; const float k = (1.f - lb) * (1.f / (1.f + expf(z)));
        float q = bf2f((short)pr[C_HQ + h * 64 + d]); q = q / (1.f + expf(-q));
#pragma unroll
        for (int j = 0; j < 8; ++j) { const float v = bf2f((short)pr[C_HI + h * 64 + e0 + j]); S[j] = f * S[j] + k * v; part[d * 64 + e0 + j] = S[j] * q; }
        __syncthreads();
        if (tid < 64) { float o = 0.f; for (int dd = 0; dd < 64; ++dd) o += part[dd * 64 + tid]; const float fast = bf2f((short)O[(long)t * 512 + tid]);
            maxdiff = fmaxf(maxdiff, fabsf(o - fast)); maxref = fmaxf(maxref, fabsf(o)); }
        __syncthreads();
    }
    if (tid < 64) {
#pragma unroll
        for (int o = 32; o > 0; o >>= 1) { maxdiff = fmaxf(maxdiff, __shfl_xor(maxdiff, o)); maxref = fmaxf(maxref, __shfl_xor(maxref, o)); }
        if (tid == 0 && !(maxdiff <= 0.03f * maxref)) atomicOr(flag, bit);
    }
    __syncthreads();
}
DI void dbg_attn(const Params& p, LAS char* lds, unsigned* flag, unsigned bit) {
    const int tid = threadIdx.x, row = tid >> 3, e0 = (tid & 7) * 16;
    const int b = 2, h = 1, r0 = 1000;
    const bf16_t* QB = (const bf16_t*)(p.ws + WS_QB); const bf16_t* KV = (const bf16_t*)(p.ws + WS_KV); const bf16_t* KR = (const bf16_t*)(p.ws + WS_KR);
    const bf16_t* OA = (const bf16_t*)(p.ws + WS_OA); const float* cs = (const float*)(p.ws + WS_COS); const float* sn = (const float*)(p.ws + WS_SIN);
    LAS float* qs = (LAS float*)lds;
    __syncthreads();
    for (int idx = tid; idx < 64 * 192; idx += 512) { const int rw = idx / 192, dd = idx % 192, pos = r0 + rw; const bf16_t* qp = QB + ((long)b * SEQ + pos) * QW + h * 192;
        float val = bf2f((short)qp[dd]);
        if (dd >= 128) { const int i = (dd - 128) & 31; const float x1 = bf2f((short)qp[128 + i]), x2 = bf2f((short)qp[160 + i]), c = cs[pos * 32 + i], s = sn[pos * 32 + i];
            val = (dd - 128 < 32) ? x1 * c - x2 * s : x1 * s + x2 * c; }
        qs[idx] = val; }
    __syncthreads();
    float m = -1e30f, l = 0.f, o[16];
#pragma unroll
    for (int j = 0; j < 16; ++j) o[j] = 0.f;
    for (int key = 0; key < SEQ; ++key) {
        const bf16_t* Kp = KV + ((long)b * SEQ + key) * KVW + h * 256; const bf16_t* Rp = KR + ((long)b * SEQ + key) * 64;
        float s = 0.f;
        for (int dd = 0; dd < 128; ++dd) s += qs[row * 192 + dd] * bf2f((short)Kp[dd]);
        for (int dd = 0; dd < 64; ++dd) s += qs[row * 192 + 128 + dd] * bf2f((short)Rp[dd]);
        s *= ATT_SCALE;
        const float mn = fmaxf(m, s), alpha = expf(m - mn), pe = expf(s - mn); l = l * alpha + pe; m = mn;
#pragma unroll
        for (int j = 0; j < 16; ++j) o[j] = o[j] * alpha + pe * bf2f((short)Kp[128 + e0 + j]);
    }
    float maxdiff = 0.f, maxref = 0.f;
#pragma unroll
    for (int j = 0; j < 16; ++j) { const float ref = o[j] / l, fast = bf2f((short)OA[((long)b * SEQ + r0 + row) * 512 + h * 128 + e0 + j]);
        maxdiff = fmaxf(maxdiff, fabsf(ref - fast)); maxref = fmaxf(maxref, fabsf(ref)); }
#pragma unroll
    for (int of = 32; of > 0; of >>= 1) { maxdiff = fmaxf(maxdiff, __shfl_xor(maxdiff, of)); maxref = fmaxf(maxref, __shfl_xor(maxref, of)); }
    if ((tid & 63) == 0 && !(maxdiff <= 0.03f * maxref)) atomicOr(flag, bit);
    __syncthreads();
}


#define XB_TMO      128
#define XB_XCNT(j)  (256  + 64 * (j))
#define XB_XSUB(j)  (1280 + 64 * (j))
#define XB_XGEN(j)  (2304 + 64 * (j))
#define XB_TOP      3328
#define XB_TOPGEN   3392
#define XCD_BAR_WORDS 3456
#define XB_SPIN_CAP (1u << 20)
DI unsigned xb_ld(unsigned* p)              { return __hip_atomic_load(p, __ATOMIC_RELAXED, __HIP_MEMORY_SCOPE_AGENT); }
DI unsigned xb_add(unsigned* p, unsigned v) { return __hip_atomic_fetch_add(p, v, __ATOMIC_RELAXED, __HIP_MEMORY_SCOPE_AGENT); }
DI unsigned xb_xcc_id() { return (unsigned)__builtin_amdgcn_s_getreg((3 << 11) | 20) & 0xFu; }
#define XB_SPIN(cond, bar) do { unsigned _sp = 0; while (cond) { __builtin_amdgcn_s_sleep(1); \
    if ((++_sp & 255u) == 0u) { if (xb_ld(&(bar)[XB_TMO])) break; if (_sp > XB_SPIN_CAP) { atomicAdd(&(bar)[XB_TMO], 1u); break; } } } } while (0)
struct XcdBarrier { unsigned* bar; unsigned x; volatile LAS unsigned* st; };
DI XcdBarrier xcd_barrier_post(unsigned* bar, volatile LAS unsigned* st) {
    XcdBarrier b; b.bar = bar; b.x = xb_xcc_id(); b.st = st;
    if (threadIdx.x == 0) (void)xb_add(&bar[XB_XCNT(b.x)], 1u);
    return b;
}
DI void xcd_barrier_complete(unsigned* bar, unsigned x, unsigned& nloc, unsigned& nx) {
    const unsigned G = gridDim.x * gridDim.y * gridDim.z;
    unsigned sum, cnt, mine, sp = 0u;
    for (;;) {
        sum = 0u; cnt = 0u; mine = 0u;
#pragma unroll
        for (unsigned j = 0; j < 16; ++j) { const unsigned c = xb_ld(&bar[XB_XCNT(j)]); sum += c; cnt += (c > 0u) ? 1u : 0u; mine = (j == x) ? c : mine; }
        if (sum == G) break;
        __builtin_amdgcn_s_sleep(1);
        if ((++sp & 255u) == 0u) { if (xb_ld(&bar[XB_TMO])) break; if (sp > XB_SPIN_CAP) { atomicAdd(&bar[XB_TMO], 1u); break; } }
    }
    nloc = mine > 0u ? mine : 1u; nx = cnt > 0u ? cnt : 1u;
}
DI void xcd_barrier(const XcdBarrier& b) {
    asm volatile("s_waitcnt vmcnt(0)" ::: "memory");
    __syncthreads();
    if (threadIdx.x == 0) {
        unsigned* bar = b.bar;
        __builtin_amdgcn_s_waitcnt(0);
        unsigned nloc = b.st[0], nx = b.st[1];
        if (nloc == 0u) { xcd_barrier_complete(bar, b.x, nloc, nx); b.st[0] = nloc; b.st[1] = nx; }
        const unsigned old = xb_add(&bar[XB_XSUB(b.x)], 1u);
        const unsigned gen = old / nloc;
        if (old + 1u == (gen + 1u) * nloc) {
            __builtin_amdgcn_fence(__ATOMIC_RELEASE, "agent");
            asm volatile("s_waitcnt vmcnt(0)" ::: "memory");
            const unsigned og = xb_add(&bar[XB_TOP], 1u);
            const unsigned tg = og / nx;
            if (og + 1u == (tg + 1u) * nx) xb_add(&bar[XB_TOPGEN], 1u);
            else XB_SPIN(xb_ld(&bar[XB_TOPGEN]) == tg, bar);
            __builtin_amdgcn_fence(__ATOMIC_ACQUIRE, "agent");
            xb_add(&bar[XB_XGEN(b.x)], 1u);
            asm volatile("s_waitcnt vmcnt(0)" ::: "memory");
        } else {
            XB_SPIN(xb_ld(&bar[XB_XGEN(b.x)]) == gen, bar);
            __builtin_amdgcn_fence(__ATOMIC_ACQUIRE, "agent");
            asm volatile("s_waitcnt vmcnt(0)" ::: "memory");
        }
    }
    __syncthreads();
}
constexpr size_t WS_BAR = WS_END;
static_assert(WS_BAR + XCD_BAR_WORDS * 4 <= (size_t)1 << 30, "barrier words");

constexpr int LDS_BYTES = GEMM_LDS + 256 + 2048;
static_assert(ATT_LDS <= LDS_BYTES && HG_LDS <= LDS_BYTES, "LDS");

__global__ void __launch_bounds__(512) mega_fwd(Params p) {
    extern __shared__ __attribute__((aligned(16))) char dyn_lds[];
    LAS char* lds = (LAS char*)dyn_lds;
    cg::grid_group grid = cg::this_grid();
    unsigned char* ws = p.ws;
    const int nw = gridDim.x * 8;
    volatile LAS unsigned* xst = (volatile LAS unsigned*)(lds + GEMM_LDS);
    if (threadIdx.x == 0) { xst[0] = 0u; xst[1] = 0u; }
    __syncthreads();
    const XcdBarrier xb = xcd_barrier_post((unsigned*)(ws + WS_BAR), xst);
#ifndef PHASE_MASK
#define PHASE_MASK 0xFFFF
#endif
#define PH(k) if constexpr ((PHASE_MASK >> (k)) & 1)
    unsigned* dbgflag = (unsigned*)(ws + WS_END);
    if (blockIdx.x == 0 && threadIdx.x == 0) *dbgflag = 0u;
    PH(0) phase0(p, fresh_gw(), nw);
    if (p.ws == nullptr) grid.sync();
    xcd_barrier(xb);
    PH(1) gemm_phase((const bf16_t*)(ws + WS_H), DM, (const bf16_t*)(ws + WS_WIN), DM, MTOK / BM, DINP / BM, EpiProj{(bf16_t*)(ws + WS_PROJ), (float*)(ws + WS_SSQQ), (float*)(ws + WS_SSQKV), (const float*)(ws + WS_OML), (const float*)(ws + WS_SSQ0)}, lds);
    xcd_barrier(xb);
    PH(2) phase_krope(p, fresh_gw(), nw);
    PH(11) for (int it = blockIdx.x; it < NBATCH * 8 * 2; it += gridDim.x) hgrn_item(p, it, lds);
    __syncthreads();
    PH(3) {
    gemm_phase((const bf16_t*)(ws + WS_PROJ) + C_CQ, DINP, (const bf16_t*)(ws + WS_WQB), QLORA, MTOK / BM, QW / BM, EpiBf16Scale{(bf16_t*)(ws + WS_QB), QW, (const float*)(ws + WS_SSQQ), 1.f / QLORA}, lds);
    gemm_phase((const bf16_t*)(ws + WS_PROJ) + C_CKV, DINP, (const bf16_t*)(ws + WS_WKVB), KVLORA, MTOK / BM, KVW / BM, EpiBf16Scale{(bf16_t*)(ws + WS_KV), KVW, (const float*)(ws + WS_SSQKV), 1.f / KVLORA}, lds);
    }
    xcd_barrier(xb);
    PH(4) for (int u = blockIdx.x; u < NBATCH * 4 * (SEQ / 256); u += gridDim.x) {
        const int cbk = (int)blockIdx.x, rnd = u / (int)gridDim.x, xcd = cbk & 7, idx = cbk >> 3;
        const int pair = (gridDim.x == 256) ? rnd * 16 + xcd * 2 + (idx >> 4) : (u >> 4), qb = (gridDim.x == 256) ? (idx & 15) : (u & 15), h = pair & 3, b = pair >> 2;
        __syncthreads();
        attn_unit((const bf16_t*)(ws + WS_QB), (const bf16_t*)(ws + WS_KV), (const bf16_t*)(ws + WS_KR), (const float*)(ws + WS_COS), (const float*)(ws + WS_SIN),
                  (bf16_t*)(ws + WS_OA), b, h, qb * 256, lds);
    }
    xcd_barrier(xb);
    PH(5) phase_mix_pre(p, fresh_gw(), nw);
    xcd_barrier(xb);
    PH(6) gemm_phase((const bf16_t*)p.out + (long)MTOK * 1024, DM, (const bf16_t*)(ws + WS_WOUT), DM, MTOK / BM, DM / BM, EpiResid<false>{(const void*)(ws + WS_H), (bf16_t*)(ws + WS_X1), (float*)(ws + WS_SSQ1)}, lds);
    xcd_barrier(xb);
    PH(8) gemm_phase((const bf16_t*)(ws + WS_X1), DM, (const bf16_t*)(ws + WS_WGU), DM, MTOK / BM, 2 * DFF / BM, EpiSwiGLU{(bf16_t*)(ws + WS_HID), (const float*)(ws + WS_SSQ1)}, lds);
    xcd_barrier(xb);
    PH(9) { if (threadIdx.x < 256) ((LAS float*)(lds + GEMM_LDS + 256))[threadIdx.x] = 0.f; __syncthreads();
            gemm_phase((const bf16_t*)(ws + WS_HID), DFF, (const bf16_t*)(ws + WS_WDN), DFF, MTOK / BM, DM / BM, EpiFinal{(const bf16_t*)(ws + WS_X1), p.out, (float*)(ws + WS_XST), p.final_norm_g, lds}, lds); }
}

extern "C" void kernel_launch(void* const* d_in, const int* in_sizes, int n_in, void* d_out, int out_size, void* d_ws, size_t ws_size, hipStream_t stream) {
    static int grid_blocks = 0;
    if (grid_blocks == 0) {
        if (n_in != 16 || in_sizes[0] != MTOK * DM || out_size != MTOK * DM || ws_size < WS_TOTAL) { fprintf(stderr, "kernel_launch: shape mismatch (n_in %d, ws %zu)\n", n_in, ws_size); grid_blocks = -1; return; }
        int dev = 0, cus = 0, per_cu = 0;
        hipGetDevice(&dev); hipDeviceGetAttribute(&cus, hipDeviceAttributeMultiprocessorCount, dev);
        if (hipFuncSetAttribute((const void*)mega_fwd, hipFuncAttributeMaxDynamicSharedMemorySize, LDS_BYTES) != hipSuccess) { fprintf(stderr, "hipFuncSetAttribute failed\n"); grid_blocks = -1; return; }
        if (hipOccupancyMaxActiveBlocksPerMultiprocessor(&per_cu, (const void*)mega_fwd, 512, LDS_BYTES) != hipSuccess || per_cu < 1) { fprintf(stderr, "occupancy query: %d\n", per_cu); per_cu = 1; }
        (void)hipGetLastError();
        grid_blocks = cus < 256 ? cus : 256;
    }
    if (grid_blocks < 0) return;
    Params p{};
    p.x = (const float*)d_in[0]; p.norm1_g = (const float*)d_in[1]; p.w_in = (const float*)d_in[2]; p.lb_logits = (const float*)d_in[3]; p.hgrn_norm_g = (const float*)d_in[4];
    p.q_a_norm_g = (const float*)d_in[5]; p.w_q_b = (const float*)d_in[6]; p.kv_a_norm_g = (const float*)d_in[7]; p.w_kv_b = (const float*)d_in[8]; p.mla_norm_g = (const float*)d_in[9];
    p.w_out = (const float*)d_in[10]; p.norm2_g = (const float*)d_in[11]; p.w_gate = (const float*)d_in[12]; p.w_up = (const float*)d_in[13]; p.w_down = (const float*)d_in[14]; p.final_norm_g = (const float*)d_in[15];
    p.out = (float*)d_out; p.ws = (unsigned char*)d_ws;
    if (hipMemsetAsync((char*)d_ws + WS_BAR, 0, XCD_BAR_WORDS * 4, stream) != hipSuccess) { fprintf(stderr, "memset of barrier words failed\n"); return; }
    void* args[] = {&p};
    hipError_t e = hipLaunchCooperativeKernel((const void*)mega_fwd, dim3(grid_blocks), dim3(512), args, LDS_BYTES, stream);
    if (e != hipSuccess) fprintf(stderr, "cooperative launch failed: %s (grid %d)\n", hipGetErrorString(e), grid_blocks);
}
```

```cpp
#include <hip/hip_runtime.h>
#include <hip/hip_cooperative_groups.h>
#include <cstdio>
#include <cstdint>
namespace cg = cooperative_groups;

typedef unsigned short bf16_t;
using bf16x8 = __attribute__((ext_vector_type(8))) short;
using s16x4  = __attribute__((ext_vector_type(4))) short;
using f32x4  = __attribute__((ext_vector_type(4))) float;
using f32x8  = __attribute__((ext_vector_type(8))) float;
using f32x16 = __attribute__((ext_vector_type(16))) float;
using u32x4  = __attribute__((ext_vector_type(4))) unsigned;
using u32x2  = __attribute__((ext_vector_type(2))) unsigned;
#define LAS __attribute__((address_space(3)))
#define DI __device__ __forceinline__

constexpr int MTOK = 65536, DM = 1024, SEQ = 4096, NBATCH = 16;
constexpr int DIN = 3264, DINP = 3328, DFF = 2816;
constexpr int QLORA = 384, KVLORA = 256, QW = 768, KVW = 1024;
constexpr float EPS = 1e-6f;
constexpr int C_HQ = 0, C_HI = 512, C_HF = 1024, C_HG = 2048, C_CQ = 2560, C_CKV = 2944, C_KR = 3200;

constexpr size_t WS_WIN  = 0;
constexpr size_t WS_WQB  = WS_WIN  + (size_t)DINP * DM * 2;
constexpr size_t WS_WKVB = WS_WQB  + (size_t)QW * QLORA * 2;
constexpr size_t WS_WOUT = WS_WKVB + (size_t)KVW * KVLORA * 2;
constexpr size_t WS_WGU  = WS_WOUT + (size_t)DM * DM * 2;
constexpr size_t WS_WDN  = WS_WGU  + (size_t)2 * DFF * DM * 2;
constexpr size_t WS_COS  = WS_WDN  + (size_t)DM * DFF * 2;
constexpr size_t WS_SIN  = WS_COS  + (size_t)SEQ * 32 * 4;
constexpr size_t WS_H    = WS_SIN  + (size_t)SEQ * 32 * 4;
constexpr size_t WS_PROJ = WS_H    + (size_t)MTOK * DM * 2;
constexpr size_t WS_HID  = WS_PROJ;
constexpr size_t WS_R2   = WS_PROJ + (size_t)MTOK * DINP * 2;
constexpr size_t WS_CQN  = WS_R2;
constexpr size_t WS_CKVN = WS_CQN  + (size_t)MTOK * QLORA * 2;
constexpr size_t WS_KR   = WS_CKVN + (size_t)MTOK * KVLORA * 2;
constexpr size_t WS_QB   = WS_KR   + (size_t)MTOK * 64 * 2;
constexpr size_t WS_KV   = WS_QB   + (size_t)MTOK * QW * 2;
constexpr size_t WS_END  = WS_KV   + (size_t)MTOK * KVW * 2;
constexpr size_t WS_OA   = WS_CQN;
constexpr size_t WS_X1   = WS_R2;
constexpr size_t WS_X2   = WS_H;
constexpr size_t WS_SSQ1 = WS_END + 16384;
constexpr size_t WS_SSQ2 = WS_SSQ1 + (size_t)MTOK * 4;
constexpr size_t WS_SSQQ = WS_SSQ2 + (size_t)MTOK * 4;
constexpr size_t WS_SSQKV = WS_SSQQ + (size_t)MTOK * 4;
constexpr size_t WS_OML = WS_SSQKV + (size_t)MTOK * 4;
constexpr size_t WS_XST = WS_OML + 2 * 512 * 4;
constexpr size_t WS_SSQ0 = WS_XST + (size_t)MTOK * 4 * 4;
constexpr size_t WS_TOTAL = WS_SSQ0 + (size_t)MTOK * 4;
static_assert(WS_TOTAL <= (size_t)1 << 30, "workspace total");
static_assert((size_t)MTOK * 512 * 2 <= (size_t)MTOK * (QLORA + KVLORA) * 2, "OA overlay");
static_assert((size_t)MTOK * DM * 4 <= WS_END - WS_R2, "X1 overlay");
static_assert(WS_END <= (size_t)1 << 30, "workspace");

struct Params {
    const float* x; const float* norm1_g; const float* w_in; const float* lb_logits; const float* hgrn_norm_g;
    const float* q_a_norm_g; const float* w_q_b; const float* kv_a_norm_g; const float* w_kv_b; const float* mla_norm_g;
    const float* w_out; const float* norm2_g; const float* w_gate; const float* w_up; const float* w_down; const float* final_norm_g;
    float* out; unsigned char* ws;
};

DI float bf2f(short u) { return __uint_as_float(((unsigned)(unsigned short)u) << 16); }
typedef __bf16 bf16x2_t __attribute__((ext_vector_type(2)));
typedef float f32x2_t __attribute__((ext_vector_type(2)));
DI unsigned cvtpk(float lo, float hi) { f32x2_t v = {lo, hi}; bf16x2_t b = __builtin_convertvector(v, bf16x2_t); return __builtin_bit_cast(unsigned, b); }
DI bf16x8 pack8(const float* v) { u32x4 w = {cvtpk(v[0], v[1]), cvtpk(v[2], v[3]), cvtpk(v[4], v[5]), cvtpk(v[6], v[7])}; return __builtin_bit_cast(bf16x8, w); }
DI float wave_sum(float v) {
#pragma unroll
    for (int o = 32; o > 0; o >>= 1) v += __shfl_xor(v, o);
    return v;
}
DI int opaque_tid() { int t = threadIdx.x; asm volatile("" : "+v"(t)); return t; }
DI int fresh_gw() { return (int)blockIdx.x * 8 + (opaque_tid() >> 6); }
DI int perm32(int rho) { const int n = rho >> 4, i = rho & 15; return 8 * (i >> 2) + 4 * n + (i & 3); }

constexpr int BM = 256, BK = 64, HALF = 128, HT = HALF * BK, GEMM_LDS = 8 * HT * 2, NXCD = 8, WGM = 8;
DI int lds_byte(int r, int c) { int st = (r >> 4) * 2 + (c >> 5), rr = r & 15, cc = c & 31, ob = rr * 64 + cc * 2; return st * 1024 + (ob ^ (((ob >> 9) & 1) << 5)); }
DI void stage_rc(int b, int& R, int& C) { int st = b / 1024, sb = b % 1024, swz = sb ^ (((sb >> 9) & 1) << 5); R = (st >> 1) * 16 + swz / 64; C = (st & 1) * 32 + (swz % 64) / 2; }

template <class Epi>
DI void gemm_unit(const bf16_t* __restrict__ A, long lda, const bf16_t* __restrict__ Bt, int K, int pm, int pn, const Epi& epi, LAS char* shmc) {
    LAS bf16_t* shm = (LAS bf16_t*)shmc;
    const int tidx = opaque_tid();
#define SA(b, h) (shm + ((b) * 2 + (h)) * HT)
#define SB(b, h) (shm + (4 + (b) * 2 + (h)) * HT)
#define STAGE(P, BASE, LD, br, kt, OFF) do { const char* _ub = (const char*)((BASE) + (long)(br) * (LD) + (long)(kt) * BK); \
    _Pragma("unroll") for (int _i = 0; _i < 2; ++_i) { \
      __builtin_amdgcn_global_load_lds((const unsigned*)(_ub + OFF[_i]), (LAS unsigned*)((LAS char*)(P) + tidx * 16 + _i * 8192), 16, 0, 0); } } while (0)
#define LDA(dst, b, h) _Pragma("unroll") for (int m = 0; m < 4; ++m) _Pragma("unroll") for (int k = 0; k < 2; ++k) \
    dst[m][k] = *reinterpret_cast<const LAS bf16x8*>((LAS char*)SA(b, h) + lds_byte(wr * 64 + m * 16 + fr, k * 32 + fq * 8))
#define LDB(dst, b, h) _Pragma("unroll") for (int n = 0; n < 2; ++n) _Pragma("unroll") for (int k = 0; k < 2; ++k) \
    dst[n][k] = *reinterpret_cast<const LAS bf16x8*>((LAS char*)SB(b, h) + lds_byte(wc * 32 + n * 16 + fr, k * 32 + fq * 8))
#define MMA(ai, bj, At, Bt_) do { __builtin_amdgcn_s_setprio(1); \
    _Pragma("unroll") for (int m = 0; m < 4; ++m) _Pragma("unroll") for (int n = 0; n < 2; ++n) _Pragma("unroll") for (int k = 0; k < 2; ++k) \
      acc[ai][bj][m][n] = __builtin_amdgcn_mfma_f32_16x16x32_bf16(Bt_[n][k], At[m][k], acc[ai][bj][m][n], 0, 0, 0); \
    __builtin_amdgcn_s_setprio(0); } while (0)
#define WAIT_V(n) asm volatile("s_waitcnt vmcnt(" #n ")" ::: "memory")
#define WAIT_L(n) asm volatile("s_waitcnt lgkmcnt(" #n ")" ::: "memory")
#define BAR __builtin_amdgcn_s_barrier()
#define SCHED __builtin_amdgcn_sched_barrier(0)
    const int brow = pm * BM, bcol = pn * BM;
    const int wid = tidx >> 6, lane = tidx & 63, wr = wid >> 2, wc = wid & 3, fr = lane & 15, fq = lane >> 4;
    f32x4 acc[2][2][4][2] = {};
    bf16x8 At[4][2], B0[2][2], B1[2][2];
    const int nt = K / BK;
    unsigned offA[2], offB[2];
#pragma unroll
    for (int _i = 0; _i < 2; ++_i) { int _r, _c; stage_rc(tidx * 16 + _i * 8192, _r, _c); offA[_i] = (unsigned)(_r * (int)lda + _c) * 2u; offB[_i] = (unsigned)(_r * K + _c) * 2u; }
    STAGE(SB(0, 0), Bt, K, bcol, 0, offB); STAGE(SA(0, 0), A, lda, brow, 0, offA);
    STAGE(SB(0, 1), Bt, K, bcol + HALF, 0, offB); STAGE(SA(0, 1), A, lda, brow + HALF, 0, offA);
    if (wr == 1) BAR;
    WAIT_V(4); BAR;
    STAGE(SB(1, 0), Bt, K, bcol, 1, offB); STAGE(SA(1, 0), A, lda, brow, 1, offA); STAGE(SB(1, 1), Bt, K, bcol + HALF, 1, offB);
    WAIT_V(6); BAR;
#pragma unroll 1
    for (int t = 0; t < nt - 2; t += 2) {
        LDB(B0, 0, 0); SCHED; LDA(At, 0, 0); STAGE(SA(1, 1), A, lda, brow + HALF, t + 1, offA);
        WAIT_L(8); BAR; WAIT_L(0); MMA(0, 0, At, B0); BAR; SCHED;
        LDB(B1, 0, 1); STAGE(SB(0, 0), Bt, K, bcol, t + 2, offB);
        BAR; WAIT_L(0); MMA(0, 1, At, B1); BAR;
        LDA(At, 0, 1); STAGE(SA(0, 0), A, lda, brow, t + 2, offA);
        BAR; WAIT_L(0); MMA(1, 0, At, B0); BAR; SCHED;
        STAGE(SB(0, 1), Bt, K, bcol + HALF, t + 2, offB);
        WAIT_V(6); BAR; MMA(1, 1, At, B1); BAR;
        LDB(B0, 1, 0); SCHED; LDA(At, 1, 0); STAGE(SA(0, 1), A, lda, brow + HALF, t + 2, offA);
        WAIT_L(8); BAR; WAIT_L(0); MMA(0, 0, At, B0); BAR; SCHED;
        LDB(B1, 1, 1); STAGE(SB(1, 0), Bt, K, bcol, t + 3, offB);
        BAR; WAIT_L(0); MMA(0, 1, At, B1); BAR;
        LDA(At, 1, 1); STAGE(SA(1, 0), A, lda, brow, t + 3, offA);
        BAR; WAIT_L(0); MMA(1, 0, At, B0); BAR; SCHED;
        STAGE(SB(1, 1), Bt, K, bcol + HALF, t + 3, offB);
        WAIT_V(6); BAR; MMA(1, 1, At, B1); BAR;
    }
    { LDB(B0, 0, 0); LDA(At, 0, 0); STAGE(SA(1, 1), A, lda, brow + HALF, nt - 1, offA);
      BAR; WAIT_L(0); MMA(0, 0, At, B0); BAR;
      LDB(B1, 0, 1); BAR; WAIT_L(0); MMA(0, 1, At, B1); BAR;
      LDA(At, 0, 1); WAIT_V(4); BAR; WAIT_L(0); MMA(1, 0, At, B0); MMA(1, 1, At, B1); BAR; }
    { LDB(B0, 1, 0); LDA(At, 1, 0); WAIT_V(2); BAR; WAIT_L(0); MMA(0, 0, At, B0); BAR;
      LDB(B1, 1, 1); WAIT_V(0); BAR; WAIT_L(0); MMA(0, 1, At, B1); BAR;
      LDA(At, 1, 1); BAR; WAIT_L(0); MMA(1, 0, At, B0); MMA(1, 1, At, B1); BAR; }
    if (wr == 0) BAR;
    epi(acc, pm, pn, wr, wc, fr, fq);
#undef SA
#undef SB
#undef STAGE
#undef LDA
#undef LDB
#undef MMA
}

DI bool unit_order(int L, int nM, int nN, int& pm, int& pn) {
    const int nwg = nM * nN; if (L >= nwg) return false;
    int wgid = L; { const int q = nwg / NXCD, r = nwg % NXCD, xcd = wgid % NXCD, off = wgid / NXCD; wgid = (xcd < r ? xcd * (q + 1) : r * (q + 1) + (xcd - r) * q) + off; }
    const int nig = WGM * nN, gid = wgid / nig, fm = gid * WGM, gsz = (nM - fm) < WGM ? (nM - fm) : WGM;
    pm = fm + ((wgid % nig) % gsz); pn = (wgid % nig) / gsz; return true;
}
template <class Epi>
DI void gemm_phase(const bf16_t* A, long lda, const bf16_t* Bt, int K, int nM, int nN, const Epi& epi, LAS char* lds) {
    for (int i = 0;; ++i) { int pm, pn; if (!unit_order(i * (int)gridDim.x + (int)blockIdx.x, nM, nN, pm, pn)) break; gemm_unit(A, lda, Bt, K, pm, pn, epi, lds); }
}

template <bool NT>
struct EpiBf16 {
    bf16_t* O; long ldc;
    DI void operator()(const f32x4 (&acc)[2][2][4][2], int pm, int pn, int wr, int wc, int fr, int fq) const {
#pragma unroll
        for (int ai = 0; ai < 2; ++ai)
#pragma unroll
            for (int m = 0; m < 4; ++m) { bf16_t* rowp = O + (long)(pm * BM + ai * HALF + wr * 64 + m * 16 + fr) * ldc + pn * BM + wc * 32 + 8 * fq;
#pragma unroll
                for (int bj = 0; bj < 2; ++bj) { const f32x4 v0 = acc[ai][bj][m][0], v1 = acc[ai][bj][m][1];
                    u32x4 w = {cvtpk(v0[0], v0[1]), cvtpk(v0[2], v0[3]), cvtpk(v1[0], v1[1]), cvtpk(v1[2], v1[3])};
                    if (NT) __builtin_nontemporal_store(w, (u32x4*)(rowp + bj * HALF)); else *(u32x4*)(rowp + bj * HALF) = w; } }
    }
};
struct EpiProj {
    bf16_t* O; float* ssq_q; float* ssq_kv; const float* oml; const float* ssq0;
    DI void operator()(const f32x4 (&acc)[2][2][4][2], int pm, int pn, int wr, int wc, int fr, int fq) const {
#pragma unroll
        for (int ai = 0; ai < 2; ++ai)
#pragma unroll
            for (int m = 0; m < 4; ++m) { const int row = pm * BM + ai * HALF + wr * 64 + m * 16 + fr; bf16_t* rowp = O + (long)row * DINP + pn * BM + wc * 32 + 8 * fq;
                float s[2];
                const float rs1 = rsqrtf(ssq0[row] * (1.f / DM) + EPS);
#pragma unroll
                for (int bj = 0; bj < 2; ++bj) { f32x4 v0 = acc[ai][bj][m][0] * rs1, v1 = acc[ai][bj][m][1] * rs1;
                    s[bj] = v0[0] * v0[0] + v0[1] * v0[1] + v0[2] * v0[2] + v0[3] * v0[3] + v1[0] * v1[0] + v1[1] * v1[1] + v1[2] * v1[2] + v1[3] * v1[3];
                    const int cat = (2 * pn + bj) >> 2;
                    if (cat == 0 || cat == 4) {
#pragma unroll
                        for (int j = 0; j < 4; ++j) { v0[j] = v0[j] * __builtin_amdgcn_rcpf(1.f + __expf(-v0[j])); v1[j] = v1[j] * __builtin_amdgcn_rcpf(1.f + __expf(-v1[j])); }
                    } else if (cat == 2 || cat == 3) {
                        const float* op = oml + (cat - 2) * 512 + (pn * BM + bj * HALF - cat * 512) + wc * 32 + 8 * fq;
                        const f32x4 m0 = *(const f32x4*)op, m1 = *(const f32x4*)(op + 4);
#pragma unroll
                        for (int j = 0; j < 4; ++j) { v0[j] = m0[j] * __builtin_amdgcn_rcpf(1.f + __expf(fminf(v0[j], 80.f))); v1[j] = m1[j] * __builtin_amdgcn_rcpf(1.f + __expf(fminf(v1[j], 80.f))); }
                    }
                    u32x4 w = {cvtpk(v0[0], v0[1]), cvtpk(v0[2], v0[3]), cvtpk(v1[0], v1[1]), cvtpk(v1[2], v1[3])};
                    __builtin_nontemporal_store(w, (u32x4*)(rowp + bj * HALF)); }
                if (pn >= 10) {
                    float sq = pn == 10 ? s[0] + s[1] : (pn == 11 ? s[0] : 0.f), sk = pn == 11 ? s[1] : (pn == 12 ? s[0] : 0.f);
                    sq += __shfl_xor(sq, 16); sq += __shfl_xor(sq, 32); sk += __shfl_xor(sk, 16); sk += __shfl_xor(sk, 32);
                    if (fq == 0) { if (pn <= 11) atomicAdd(ssq_q + row, sq); if (pn >= 11) atomicAdd(ssq_kv + row, sk); } } }
    }
};
struct EpiBf16Scale {
    bf16_t* O; long ldc; const float* ssq; float inv_k;
    DI void operator()(const f32x4 (&acc)[2][2][4][2], int pm, int pn, int wr, int wc, int fr, int fq) const {
#pragma unroll
        for (int ai = 0; ai < 2; ++ai)
#pragma unroll
            for (int m = 0; m < 4; ++m) { const int row = pm * BM + ai * HALF + wr * 64 + m * 16 + fr; bf16_t* rowp = O + (long)row * ldc + pn * BM + wc * 32 + 8 * fq;
                const float rs = rsqrtf(ssq[row] * inv_k + EPS);
#pragma unroll
                for (int bj = 0; bj < 2; ++bj) { const f32x4 v0 = acc[ai][bj][m][0] * rs, v1 = acc[ai][bj][m][1] * rs;
                    u32x4 w = {cvtpk(v0[0], v0[1]), cvtpk(v0[2], v0[3]), cvtpk(v1[0], v1[1]), cvtpk(v1[2], v1[3])};
                    *(u32x4*)(rowp + bj * HALF) = w; }
                asm volatile("" ::: "memory"); }
    }
};
template <bool R_F32>
struct EpiResid {
    const void* R; bf16_t* O; float* ssq;
    DI void operator()(const f32x4 (&acc)[2][2][4][2], int pm, int pn, int wr, int wc, int fr, int fq) const {
#pragma unroll
        for (int ai = 0; ai < 2; ++ai)
#pragma unroll
            for (int m = 0; m < 4; ++m) { const int row = pm * BM + ai * HALF + wr * 64 + m * 16 + fr; const long off = (long)row * DM + pn * BM + wc * 32 + 8 * fq;
                float s = 0.f;
#pragma unroll
                for (int bj = 0; bj < 2; ++bj) {
                    float v[8];
                    if (R_F32) { const f32x4 r0 = *(const f32x4*)((const float*)R + off + bj * HALF), r1 = *(const f32x4*)((const float*)R + off + bj * HALF + 4);
#pragma unroll
                        for (int j = 0; j < 4; ++j) { v[j] = r0[j] + acc[ai][bj][m][0][j]; v[4 + j] = r1[j] + acc[ai][bj][m][1][j]; }
                    } else { const bf16x8 r = *(const bf16x8*)((const bf16_t*)R + off + bj * HALF);
#pragma unroll
                        for (int j = 0; j < 4; ++j) { v[j] = bf2f(r[j]) + acc[ai][bj][m][0][j]; v[4 + j] = bf2f(r[4 + j]) + acc[ai][bj][m][1][j]; } }
#pragma unroll
                    for (int j = 0; j < 8; ++j) s += v[j] * v[j];
                    *(bf16x8*)(O + off + bj * HALF) = pack8(v); }
                s += __shfl_xor(s, 16); s += __shfl_xor(s, 32);
                if (fq == 0) atomicAdd(ssq + row, s); }
    }
};
struct EpiFinal {
    const bf16_t* R; float* out; float* xst; const float* g; LAS char* lds;
    DI void operator()(const f32x4 (&acc)[2][2][4][2], int pm, int pn, int wr, int wc, int fr, int fq) const {
        LAS float* rowss = (LAS float*)(lds + GEMM_LDS + 256); LAS float* rsl = rowss + 256;
#pragma unroll
        for (int ai = 0; ai < 2; ++ai)
#pragma unroll
            for (int m = 0; m < 4; ++m) { const int rl = ai * HALF + wr * 64 + m * 16 + fr; const long off = (long)(pm * BM + rl) * DM + pn * BM + wc * 32 + 8 * fq;
                float s = 0.f;
#pragma unroll
                for (int bj = 0; bj < 2; ++bj) { const bf16x8 r = *(const bf16x8*)(R + off + bj * HALF);
#pragma unroll
                    for (int j = 0; j < 4; ++j) { const float a = bf2f(r[j]) + acc[ai][bj][m][0][j], b = bf2f(r[4 + j]) + acc[ai][bj][m][1][j]; s += a * a + b * b; } }
                s += __shfl_xor(s, 16); s += __shfl_xor(s, 32);
                if (fq == 0) (void)__hip_atomic_fetch_add(rowss + rl, s, __ATOMIC_RELAXED, __HIP_MEMORY_SCOPE_WORKGROUP); }
        __syncthreads();
        const int tid = opaque_tid();
        if (tid < 256) { const float mine = rowss[tid]; rowss[tid] = 0.f;
            float* slot = xst + (long)(pm * BM + tid) * 4;
            __hip_atomic_store(slot + pn, mine, __ATOMIC_RELAXED, __HIP_MEMORY_SCOPE_AGENT);
            float tot = 0.f;
#pragma unroll
            for (int q = 0; q < 4; ++q) { float v = mine;
                if (q != pn) { unsigned sp = 0; v = __hip_atomic_load(slot + q, __ATOMIC_RELAXED, __HIP_MEMORY_SCOPE_AGENT);
                    while (v < 0.f && ++sp < (1u << 22)) { __builtin_amdgcn_s_sleep(1); v = __hip_atomic_load(slot + q, __ATOMIC_RELAXED, __HIP_MEMORY_SCOPE_AGENT); } }
                tot += v; }
            rsl[tid] = rsqrtf(tot * (1.f / DM) + EPS); }
        __syncthreads();
        const float* gp = g + pn * BM + wc * 32 + 8 * fq;
        f32x4 gv[2][2];
#pragma unroll
        for (int bj = 0; bj < 2; ++bj) { gv[bj][0] = *(const f32x4*)(gp + bj * HALF); gv[bj][1] = *(const f32x4*)(gp + bj * HALF + 4); }
#pragma unroll
        for (int ai = 0; ai < 2; ++ai)
#pragma unroll
            for (int m = 0; m < 4; ++m) { const int rl = ai * HALF + wr * 64 + m * 16 + fr; const long off = (long)(pm * BM + rl) * DM + pn * BM + wc * 32 + 8 * fq;
                const float rs = rsl[rl];
#pragma unroll
                for (int bj = 0; bj < 2; ++bj) { const bf16x8 r = *(const bf16x8*)(R + off + bj * HALF);
                    f32x4 a, b;
#pragma unroll
                    for (int j = 0; j < 4; ++j) { a[j] = (bf2f(r[j]) + acc[ai][bj][m][0][j]) * rs * gv[bj][0][j]; b[j] = (bf2f(r[4 + j]) + acc[ai][bj][m][1][j]) * rs * gv[bj][1][j]; }
                    __builtin_nontemporal_store(a, (f32x4*)(out + off + bj * HALF)); __builtin_nontemporal_store(b, (f32x4*)(out + off + bj * HALF + 4)); } }
    }
};
struct EpiSwiGLU {
    bf16_t* O; const float* ssq;
    DI void operator()(const f32x4 (&acc)[2][2][4][2], int pm, int pn, int wr, int wc, int fr, int fq) const {
#pragma unroll
        for (int ai = 0; ai < 2; ++ai)
#pragma unroll
            for (int m = 0; m < 4; ++m) { const int row = pm * BM + ai * HALF + wr * 64 + m * 16 + fr; bf16_t* rowp = O + (long)row * DFF + pn * HALF + wc * 32 + 8 * fq;
                const float rs = rsqrtf(ssq[row] * (1.f / DM) + EPS);
                float h[8];
#pragma unroll
                for (int n = 0; n < 2; ++n)
#pragma unroll
                    for (int j = 0; j < 4; ++j) { const float g = acc[ai][0][m][n][j] * rs, u = acc[ai][1][m][n][j] * rs; h[n * 4 + j] = g * __builtin_amdgcn_rcpf(1.f + __expf(-g)) * u; }
                __builtin_nontemporal_store(pack8(h), (bf16x8*)rowp); }
    }
};

template <class Src, class RowMap>
DI void wt_convert(bf16_t* Wt, int K, int Npad, const Src& src, const RowMap& rowmap, int gw, int nw) {
    const int lane = opaque_tid() & 63, nl = lane & 15, kq = lane >> 4;
    const int nblocks = Npad / 16, items = nblocks * (K / 32);
    for (int it = gw; it < items; it += nw) {
        const int nb = it % nblocks, kb = it / nblocks, n = nb * 16 + nl, k0 = kb * 32 + kq * 8;
        float v[8];
#pragma unroll
        for (int i = 0; i < 8; ++i) v[i] = src(k0 + i, n);
        *(bf16x8*)(Wt + (long)rowmap(n) * K + k0) = pack8(v);
    }
}
template <bool OUT_F32>
DI void rmsnorm_rows(const float* X, const float* g, void* Out, int gw, int nw) {
    constexpr int RB = 4;
    const int lane = opaque_tid() & 63;
    f32x4 gv[4];
#pragma unroll
    for (int i = 0; i < 2; ++i) { gv[2 * i] = *(const f32x4*)(g + lane * 8 + 512 * i); gv[2 * i + 1] = *(const f32x4*)(g + lane * 8 + 512 * i + 4); }
    for (int row0 = gw * RB; row0 < MTOK; row0 += nw * RB) {
        f32x4 v[RB][4];
#pragma unroll
        for (int r = 0; r < RB; ++r) { const float* xr = X + (long)(row0 + r) * DM;
#pragma unroll
            for (int i = 0; i < 2; ++i) { v[r][2 * i] = __builtin_nontemporal_load((const f32x4*)(xr + lane * 8 + 512 * i)); v[r][2 * i + 1] = __builtin_nontemporal_load((const f32x4*)(xr + lane * 8 + 512 * i + 4)); } }
#pragma unroll
        for (int r = 0; r < RB; ++r) {
            float ss = 0.f;
#pragma unroll
            for (int i = 0; i < 4; ++i) ss += v[r][i][0] * v[r][i][0] + v[r][i][1] * v[r][i][1] + v[r][i][2] * v[r][i][2] + v[r][i][3] * v[r][i][3];
            ss = wave_sum(ss);
            const float rs = rsqrtf(ss * (1.f / DM) + EPS);
#pragma unroll
            for (int i = 0; i < 4; ++i) v[r][i] = v[r][i] * rs * gv[i];
            if (OUT_F32) { float* o = (float*)Out + (long)(row0 + r) * DM;
#pragma unroll
                for (int i = 0; i < 2; ++i) { *(f32x4*)(o + lane * 8 + 512 * i) = v[r][2 * i]; *(f32x4*)(o + lane * 8 + 512 * i + 4) = v[r][2 * i + 1]; }
            } else { bf16_t* o = (bf16_t*)Out + (long)(row0 + r) * DM;
#pragma unroll
                for (int i = 0; i < 2; ++i) { u32x4 w = {cvtpk(v[r][2 * i][0], v[r][2 * i][1]), cvtpk(v[r][2 * i][2], v[r][2 * i][3]), cvtpk(v[r][2 * i + 1][0], v[r][2 * i + 1][1]), cvtpk(v[r][2 * i + 1][2], v[r][2 * i + 1][3])};
                    *(u32x4*)(o + lane * 8 + 512 * i) = w; }
            }
        }
    }
}

DI void xcast_rows(const float* X, bf16_t* Out, float* ssq, int gw, int nw) {
    constexpr int RB = 4;
    const int lane = opaque_tid() & 63;
    for (int row0 = gw * RB; row0 < MTOK; row0 += nw * RB) {
        f32x4 v[RB][4];
#pragma unroll
        for (int r = 0; r < RB; ++r) { const float* xr = X + (long)(row0 + r) * DM;
#pragma unroll
            for (int i = 0; i < 2; ++i) { v[r][2 * i] = __builtin_nontemporal_load((const f32x4*)(xr + lane * 8 + 512 * i)); v[r][2 * i + 1] = __builtin_nontemporal_load((const f32x4*)(xr + lane * 8 + 512 * i + 4)); } }
#pragma unroll
        for (int r = 0; r < RB; ++r) {
            float ss = 0.f;
#pragma unroll
            for (int i = 0; i < 4; ++i) ss += v[r][i][0] * v[r][i][0] + v[r][i][1] * v[r][i][1] + v[r][i][2] * v[r][i][2] + v[r][i][3] * v[r][i][3];
            ss = wave_sum(ss);
            if (lane == 0) ssq[row0 + r] = ss;
            bf16_t* o = Out + (long)(row0 + r) * DM;
#pragma unroll
            for (int i = 0; i < 2; ++i) { u32x4 w = {cvtpk(v[r][2 * i][0], v[r][2 * i][1]), cvtpk(v[r][2 * i][2], v[r][2 * i][3]), cvtpk(v[r][2 * i + 1][0], v[r][2 * i + 1][1]), cvtpk(v[r][2 * i + 1][2], v[r][2 * i + 1][3])};
                *(u32x4*)(o + lane * 8 + 512 * i) = w; }
        }
    }
}
DI void phase0(const Params& p, int gw0, int nw0) {
    unsigned char* ws = p.ws;
    const int wib = gw0 & 7, gw = (gw0 >> 3) * 4 + (wib & 3), nw = nw0 >> 1;
    if (wib < 4) { xcast_rows(p.x, (bf16_t*)(ws + WS_H), (float*)(ws + WS_SSQ0), gw, nw); return; }
    { const float* W = p.w_in; const float* g1 = p.norm1_g; wt_convert((bf16_t*)(ws + WS_WIN), DM, DINP, [=](int k, int n) { const int c = (n & ~31) + perm32(n & 31); return c < DIN ? W[(long)k * DIN + c] * g1[k] : 0.f; }, [](int n) { return n; }, gw, nw); }
    { const float* W = p.w_q_b; const float* gq = p.q_a_norm_g; wt_convert((bf16_t*)(ws + WS_WQB), QLORA, QW, [=](int k, int n) { const int c = (n & ~31) + perm32(n & 31); return W[(long)k * QW + c] * gq[k]; }, [](int n) { return n; }, gw, nw); }
    { const float* W = p.w_kv_b; const float* gk = p.kv_a_norm_g; wt_convert((bf16_t*)(ws + WS_WKVB), KVLORA, KVW, [=](int k, int n) { const int c = (n & ~31) + perm32(n & 31); return W[(long)k * KVW + c] * gk[k]; }, [](int n) { return n; }, gw, nw); }
    { const float* W = p.w_out; wt_convert((bf16_t*)(ws + WS_WOUT), DM, DM, [=](int k, int n) { const int c = (n & ~31) + perm32(n & 31); return W[(long)k * DM + c]; }, [](int n) { return n; }, gw, nw); }
    { const float* W = p.w_gate; const float* g2 = p.norm2_g; wt_convert((bf16_t*)(ws + WS_WGU), DM, DFF, [=](int k, int n) { const int c = (n & ~31) + perm32(n & 31); return W[(long)k * DFF + c] * g2[k]; },
                                            [](int n) { return (n >> 7) * 256 + (n & 127); }, gw, nw); }
    { const float* W = p.w_up; const float* g2 = p.norm2_g; wt_convert((bf16_t*)(ws + WS_WGU), DM, DFF, [=](int k, int n) { const int c = (n & ~31) + perm32(n & 31); return W[(long)k * DFF + c] * g2[k]; },
                                          [](int n) { return (n >> 7) * 256 + 128 + (n & 127); }, gw, nw); }
    { const float* W = p.w_down; wt_convert((bf16_t*)(ws + WS_WDN), DFF, DM, [=](int k, int n) { const int c = (n & ~31) + perm32(n & 31); return W[(long)k * DM + c]; }, [](int n) { return n; }, gw, nw); }
    { float* cs = (float*)(ws + WS_COS); float* sn = (float*)(ws + WS_SIN); const int lane = opaque_tid() & 63;
      for (int idx = gw * 64 + lane; idx < SEQ * 32; idx += nw * 64) { const int pos = idx >> 5, i = idx & 31;
          const float inv = 1.0f / powf(10000.0f, (float)(2 * i) / 64.0f); const float ang = (float)pos * inv; float s, c; sincosf(ang, &s, &c); cs[idx] = c; sn[idx] = s; } }
    { float* om = (float*)(ws + WS_OML); const int lane = opaque_tid() & 63; const int idx = gw * 64 + lane;
      if (idx < 1024) { const int dir = idx >> 9, c = idx & 511; const float a0 = p.lb_logits[dir * 1024 + c], a1 = p.lb_logits[dir * 1024 + 512 + c]; om[idx] = 1.f - 1.f / (1.f + expf(a1 - a0)); } }
    { float* xs = (float*)(ws + WS_XST); const int lane = opaque_tid() & 63; for (int idx = gw * 64 + lane; idx < 4 * MTOK; idx += nw * 64) xs[idx] = -1.f; }
    { float* z = (float*)(ws + WS_SSQ1); const int lane = opaque_tid() & 63; for (int idx = gw * 64 + lane; idx < 4 * MTOK; idx += nw * 64) z[idx] = 0.f; }
}
DI void phase_final(const Params& p, int gw, int nw) {
    constexpr int RB = 4;
    const int lane = opaque_tid() & 63;
    const bf16_t* X2 = (const bf16_t*)(p.ws + WS_X2); const float* ssq = (const float*)(p.ws + WS_SSQ2);
    f32x4 gv[4];
#pragma unroll
    for (int i = 0; i < 2; ++i) { gv[2 * i] = *(const f32x4*)(p.final_norm_g + lane * 8 + 512 * i); gv[2 * i + 1] = *(const f32x4*)(p.final_norm_g + lane * 8 + 512 * i + 4); }
    for (int row0 = gw * RB; row0 < MTOK; row0 += nw * RB) {
        bf16x8 v[RB][2]; float rs[RB];
#pragma unroll
        for (int r = 0; r < RB; ++r) { const bf16_t* xr = X2 + (long)(row0 + r) * DM; v[r][0] = *(const bf16x8*)(xr + lane * 8); v[r][1] = *(const bf16x8*)(xr + lane * 8 + 512); rs[r] = rsqrtf(ssq[row0 + r] * (1.f / DM) + EPS); }
#pragma unroll
        for (int r = 0; r < RB; ++r) { float* o = p.out + (long)(row0 + r) * DM;
#pragma unroll
            for (int i = 0; i < 2; ++i) { f32x4 a, b;
#pragma unroll
                for (int j = 0; j < 4; ++j) { a[j] = bf2f(v[r][i][j]) * rs[r] * gv[2 * i][j]; b[j] = bf2f(v[r][i][4 + j]) * rs[r] * gv[2 * i + 1][j]; }
                __builtin_nontemporal_store(a, (f32x4*)(o + lane * 8 + 512 * i)); __builtin_nontemporal_store(b, (f32x4*)(o + lane * 8 + 512 * i + 4)); } }
    }
}

DI void phase_mla_pre(const Params& p, int gw, int nw) {
    unsigned char* ws = p.ws; const int lane = opaque_tid() & 63;
    const bf16_t* proj = (const bf16_t*)(ws + WS_PROJ); bf16_t* cqn = (bf16_t*)(ws + WS_CQN); bf16_t* ckvn = (bf16_t*)(ws + WS_CKVN); bf16_t* kr = (bf16_t*)(ws + WS_KR);
    const float* cs = (const float*)(ws + WS_COS); const float* sn = (const float*)(ws + WS_SIN);
    float gq[8], gk[8];
#pragma unroll
    for (int j = 0; j < 8; ++j) { gq[j] = lane < 48 ? p.q_a_norm_g[lane * 8 + j] : 0.f; gk[j] = lane < 32 ? p.kv_a_norm_g[lane * 8 + j] : 0.f; }
    constexpr int RB = 4;
    for (int row0 = gw * RB; row0 < MTOK; row0 += nw * RB) {
        bf16x8 a[RB], b[RB], x1[RB], x2[RB];
#pragma unroll
        for (int r = 0; r < RB; ++r) { const bf16_t* pr = proj + (long)(row0 + r) * DINP; a[r] = bf16x8{}; b[r] = bf16x8{}; x1[r] = bf16x8{}; x2[r] = bf16x8{};
            if (lane < 48) a[r] = *(const bf16x8*)(pr + C_CQ + lane * 8);
            if (lane < 32) b[r] = *(const bf16x8*)(pr + C_CKV + lane * 8);
            if (lane < 4) { x1[r] = *(const bf16x8*)(pr + C_KR + lane * 8); x2[r] = *(const bf16x8*)(pr + C_KR + 32 + lane * 8); } }
#pragma unroll
        for (int r = 0; r < RB; ++r) { const int row = row0 + r;
            float fa[8], fb[8], sa = 0.f, sb = 0.f;
#pragma unroll
            for (int j = 0; j < 8; ++j) { fa[j] = bf2f(a[r][j]); fb[j] = bf2f(b[r][j]); sa += fa[j] * fa[j]; sb += fb[j] * fb[j]; }
            sa = wave_sum(sa); sb = wave_sum(sb);
            const float ra = rsqrtf(sa * (1.f / QLORA) + EPS), rb = rsqrtf(sb * (1.f / KVLORA) + EPS);
#pragma unroll
            for (int j = 0; j < 8; ++j) { fa[j] *= ra * gq[j]; fb[j] *= rb * gk[j]; }
            if (lane < 48) *(bf16x8*)(cqn + (long)row * QLORA + lane * 8) = pack8(fa);
            if (lane < 32) *(bf16x8*)(ckvn + (long)row * KVLORA + lane * 8) = pack8(fb);
            if (lane < 4) { const int pos = row & (SEQ - 1);
                float o1[8], o2[8];
#pragma unroll
                for (int j = 0; j < 8; ++j) { const float c = cs[pos * 32 + lane * 8 + j], s = sn[pos * 32 + lane * 8 + j], f1 = bf2f(x1[r][j]), f2 = bf2f(x2[r][j]); o1[j] = f1 * c - f2 * s; o2[j] = f1 * s + f2 * c; }
                *(bf16x8*)(kr + (long)row * 64 + lane * 8) = pack8(o1); *(bf16x8*)(kr + (long)row * 64 + 32 + lane * 8) = pack8(o2); }
        }
    }
}

DI void phase_krope(const Params& p, int gw, int nw) {
    unsigned char* ws = p.ws; const int lane = opaque_tid() & 63, rl = lane >> 2, ch = lane & 3;
    const bf16_t* proj = (const bf16_t*)(ws + WS_PROJ); bf16_t* kr = (bf16_t*)(ws + WS_KR);
    const float* cs = (const float*)(ws + WS_COS); const float* sn = (const float*)(ws + WS_SIN);
    for (int row0 = gw * 16; row0 < MTOK; row0 += nw * 16) { const int row = row0 + rl, pos = row & (SEQ - 1);
        const bf16_t* pr = proj + (long)row * DINP + C_KR + ch * 8;
        const bf16x8 x1 = *(const bf16x8*)pr, x2 = *(const bf16x8*)(pr + 32);
        const f32x4 c0 = *(const f32x4*)(cs + pos * 32 + ch * 8), c1 = *(const f32x4*)(cs + pos * 32 + ch * 8 + 4), s0 = *(const f32x4*)(sn + pos * 32 + ch * 8), s1 = *(const f32x4*)(sn + pos * 32 + ch * 8 + 4);
        float o1[8], o2[8];
#pragma unroll
        for (int j = 0; j < 8; ++j) { const float c = j < 4 ? c0[j & 3] : c1[j & 3], s = j < 4 ? s0[j & 3] : s1[j & 3], f1 = bf2f(x1[j]), f2 = bf2f(x2[j]); o1[j] = f1 * c - f2 * s; o2[j] = f1 * s + f2 * c; }
        *(bf16x8*)(kr + (long)row * 64 + ch * 8) = pack8(o1); *(bf16x8*)(kr + (long)row * 64 + 32 + ch * 8) = pack8(o2); }
}

DI void phase_mix_pre(const Params& p, int gw, int nw) {
    unsigned char* ws = p.ws; const int lane = opaque_tid() & 63;
    const bf16_t* proj = (const bf16_t*)(ws + WS_PROJ); const bf16_t* OF = (const bf16_t*)p.out; const bf16_t* OB = OF + (long)MTOK * 512;
    const bf16_t* OA = (const bf16_t*)(ws + WS_OA); bf16_t* Y = (bf16_t*)p.out + (long)MTOK * 1024;
    float gh[8], gm[8];
#pragma unroll
    for (int j = 0; j < 8; ++j) { gh[j] = p.hgrn_norm_g[lane * 8 + j]; gm[j] = p.mla_norm_g[lane * 8 + j]; }
    constexpr int RB = 4;
    for (int row0 = gw * RB; row0 < MTOK; row0 += nw * RB) {
        bf16x8 of[RB], ob[RB], hg[RB], oa[RB];
#pragma unroll
        for (int r = 0; r < RB; ++r) { const long row = row0 + r;
            of[r] = *(const bf16x8*)(OF + row * 512 + lane * 8); ob[r] = *(const bf16x8*)(OB + row * 512 + lane * 8);
            hg[r] = *(const bf16x8*)(proj + row * DINP + C_HG + lane * 8); oa[r] = *(const bf16x8*)(OA + row * 512 + lane * 8); }
#pragma unroll
        for (int r = 0; r < RB; ++r) { const long row = row0 + r;
            float o[8], a[8], so = 0.f, sa = 0.f;
#pragma unroll
            for (int j = 0; j < 8; ++j) { o[j] = bf2f(of[r][j]) + bf2f(ob[r][j]); a[j] = bf2f(oa[r][j]); so += o[j] * o[j]; sa += a[j] * a[j]; }
            so += __shfl_xor(so, 1); so += __shfl_xor(so, 2); so += __shfl_xor(so, 4);
            sa = wave_sum(sa);
            const float ro = rsqrtf(so * (1.f / 64.f) + EPS), ra = rsqrtf(sa * (1.f / 512.f) + EPS);
#pragma unroll
            for (int j = 0; j < 8; ++j) { o[j] = o[j] * ro * gh[j] * bf2f(hg[r][j]);     a[j] = a[j] * ra * gm[j]; }
            *(bf16x8*)(Y + row * DM + lane * 8) = pack8(o); *(bf16x8*)(Y + row * DM + 512 + lane * 8) = pack8(a);
        }
    }
}

constexpr int ATT_SHM_V = 64 * 128 * 2, ATT_SHM_K = 64 * 128 * 2, ATT_SHM_R = 64 * 64 * 2;
constexpr int ATT_OFF_K = 2 * ATT_SHM_V, ATT_OFF_R = ATT_OFF_K + 2 * ATT_SHM_K, ATT_OFF_W = ATT_OFF_R + 2 * ATT_SHM_R, ATT_OFF_Q = ATT_OFF_W + 8 * 64 * 4, ATT_LDS = ATT_OFF_Q + 8 * 4 * 64 * 16;
constexpr float ATT_SCALE = 0.07216878364870322f;
constexpr float ATT_THR = 8.f;
#define KSWZ(row, colB) ((row) * 256 + ((colB) ^ (((row) & 15) << 4)))
#define RSWZ(row, colB) ((row) * 128 + ((colB) ^ ((((row) >> 1) & 7) << 4)))
#define SBAR() __builtin_amdgcn_sched_barrier(0)
DI int crow(int r, int hi) { return (r & 3) + 8 * (r >> 2) + 4 * hi; }

DI void partialSM(f32x16& p0, f32x16& p1, float& m_reg, float& mn, float& alpha) {
    constexpr float C = ATT_SCALE * 1.4426950408889634f;
    float pmax = p0[0];
#pragma unroll
    for (int r = 1; r < 16; ++r) pmax = fmaxf(pmax, p0[r]);
#pragma unroll
    for (int r = 0; r < 16; ++r) pmax = fmaxf(pmax, p1[r]);
    { auto rr = __builtin_amdgcn_permlane32_swap(__float_as_uint(pmax), __float_as_uint(pmax), false, false);
      pmax = fmaxf(__uint_as_float(rr[0]), __uint_as_float(rr[1])); }
    if (__builtin_expect(__all(pmax - m_reg <= ATT_THR / ATT_SCALE), 1)) { mn = m_reg; alpha = 1.f; }
    else { mn = fmaxf(m_reg, pmax); alpha = __builtin_amdgcn_exp2f((m_reg - mn) * C); m_reg = mn; }
    const float mnC = -mn * C;
#pragma unroll
    for (int r = 0; r < 16; ++r) p0[r] = fmaf(p0[r], C, mnC);
#pragma unroll
    for (int r = 0; r < 16; ++r) p1[r] = fmaf(p1[r], C, mnC);
#pragma unroll
    for (int r = 0; r < 16; ++r) p0[r] = __builtin_amdgcn_exp2f(p0[r]);
}
DI void finishSM(f32x16& p0, f32x16& p1, float alpha, float& l_reg, bf16x8& pa0, bf16x8& pa1, bf16x8& pa2, bf16x8& pa3) {
#pragma unroll
    for (int r = 0; r < 16; ++r) p1[r] = __builtin_amdgcn_exp2f(p1[r]);
    float ps = 0;
#pragma unroll
    for (int r = 0; r < 16; ++r) ps += p0[r];
#pragma unroll
    for (int r = 0; r < 16; ++r) ps += p1[r];
    { auto rr = __builtin_amdgcn_permlane32_swap(__float_as_uint(ps), __float_as_uint(ps), false, false);
      ps = __uint_as_float(rr[0]) + __uint_as_float(rr[1]); }
    l_reg = l_reg * alpha + ps;
#define PK4(P, BASE, OUT) do { unsigned a0 = cvtpk(P[BASE + 0], P[BASE + 1]), a1 = cvtpk(P[BASE + 2], P[BASE + 3]);   \
    unsigned b0 = cvtpk(P[BASE + 4], P[BASE + 5]), b1 = cvtpk(P[BASE + 6], P[BASE + 7]);                              \
    auto r0 = __builtin_amdgcn_permlane32_swap(a0, b0, false, false); auto r1 = __builtin_amdgcn_permlane32_swap(a1, b1, false, false); \
    u32x4 w = {r0[0], r1[0], r0[1], r1[1]}; OUT = __builtin_bit_cast(bf16x8, w); } while (0)
    PK4(p0, 0, pa0); PK4(p0, 8, pa1); PK4(p1, 0, pa2); PK4(p1, 8, pa3);
#undef PK4
}
DI void qkt(f32x16& p0, f32x16& p1, const LAS char* Ks, const LAS char* Rs, const bf16x8* qr, const LAS bf16x8* qrl, int r32, int hi) {
    p0 = f32x16{}; p1 = f32x16{};
    __builtin_amdgcn_s_setprio(1);
#pragma unroll
    for (int d0 = 0; d0 < 8; ++d0) { const int cb = (d0 * 16 + hi * 8) * 2;
        const bf16x8 b0 = *reinterpret_cast<const LAS bf16x8*>(Ks + KSWZ(r32, cb));
        const bf16x8 b1 = *reinterpret_cast<const LAS bf16x8*>(Ks + KSWZ(32 + r32, cb));
        p0 = __builtin_amdgcn_mfma_f32_32x32x16_bf16(b0, qr[d0], p0, 0, 0, 0);
        p1 = __builtin_amdgcn_mfma_f32_32x32x16_bf16(b1, qr[d0], p1, 0, 0, 0); }
#pragma unroll
    for (int d0 = 0; d0 < 4; ++d0) { const int cb = (d0 * 16 + hi * 8) * 2;
        const bf16x8 b0 = *reinterpret_cast<const LAS bf16x8*>(Rs + RSWZ(r32, cb));
        const bf16x8 b1 = *reinterpret_cast<const LAS bf16x8*>(Rs + RSWZ(32 + r32, cb));
        const bf16x8 qv = qrl[d0 * 64];
        p0 = __builtin_amdgcn_mfma_f32_32x32x16_bf16(b0, qv, p0, 0, 0, 0);
        p1 = __builtin_amdgcn_mfma_f32_32x32x16_bf16(b1, qv, p1, 0, 0, 0); }
    __builtin_amdgcn_s_setprio(0);
}
DI int v_st(int k, int c) { const int kk = (k & ~0xC) | ((k & 4) << 1) | ((k & 8) >> 1); return ((kk >> 3) * 4 + (c >> 5)) * 512 + ((kk & 7) * 32 + (c & 31)) * 2; }
DI int v_rd_base(int lane) { return ((lane & 3) << 3) | (((lane >> 2) & 3) << 6) | (((lane >> 4) & 1) << 5) | (((lane >> 5) & 1) << 8); }
constexpr int v_rd_off(int d0, int ks, int half) { return d0 * 512 + ks * 4096 + half * 2048; }
template <int OFF> DI s16x4 tr_read(int vb) { s16x4 r; asm volatile("ds_read_b64_tr_b16 %0, %1 offset:%2" : "=&v"(r) : "v"(vb), "i"(OFF) : "memory"); return r; }
template <int D0> DI void pv_one(f32x16& od, int vb, bf16x8 pa0, bf16x8 pa1, bf16x8 pa2, bf16x8 pa3) {
    const s16x4 l0 = tr_read<v_rd_off(D0, 0, 0)>(vb), h0 = tr_read<v_rd_off(D0, 0, 1)>(vb), l1 = tr_read<v_rd_off(D0, 1, 0)>(vb), h1 = tr_read<v_rd_off(D0, 1, 1)>(vb);
    const s16x4 l2 = tr_read<v_rd_off(D0, 2, 0)>(vb), h2 = tr_read<v_rd_off(D0, 2, 1)>(vb), l3 = tr_read<v_rd_off(D0, 3, 0)>(vb), h3 = tr_read<v_rd_off(D0, 3, 1)>(vb);
    asm volatile("s_waitcnt lgkmcnt(0)" ::: "memory"); SBAR();
#define PK(L, H) (bf16x8){L[0], L[1], L[2], L[3], H[0], H[1], H[2], H[3]}
    __builtin_amdgcn_s_setprio(1);
    od = __builtin_amdgcn_mfma_f32_32x32x16_bf16(pa0, PK(l0, h0), od, 0, 0, 0);
    od = __builtin_amdgcn_mfma_f32_32x32x16_bf16(pa1, PK(l1, h1), od, 0, 0, 0);
    od = __builtin_amdgcn_mfma_f32_32x32x16_bf16(pa2, PK(l2, h2), od, 0, 0, 0);
    od = __builtin_amdgcn_mfma_f32_32x32x16_bf16(pa3, PK(l3, h3), od, 0, 0, 0);
    __builtin_amdgcn_s_setprio(0);
#undef PK
}
DI void pv_d0(f32x16* o, int vb, bf16x8 pa0, bf16x8 pa1, bf16x8 pa2, bf16x8 pa3) {
    pv_one<0>(o[0], vb, pa0, pa1, pa2, pa3); pv_one<1>(o[1], vb, pa0, pa1, pa2, pa3); pv_one<2>(o[2], vb, pa0, pa1, pa2, pa3); pv_one<3>(o[3], vb, pa0, pa1, pa2, pa3);
}

DI void attn_unit(const bf16_t* __restrict__ QB, const bf16_t* __restrict__ KVb, const bf16_t* __restrict__ KRb, const float* __restrict__ cs, const float* __restrict__ sn,
                  bf16_t* __restrict__ OA, int b, int h, int i0, LAS char* lds) {
    const int tid = opaque_tid(), wid = tid >> 6, lane = tid & 63, r32 = lane & 31, hi = lane >> 5;
    LAS char* V_lds = lds; LAS char* K_lds = lds + ATT_OFF_K; LAS char* R_lds = lds + ATT_OFF_R;
    LAS float* wsl = (LAS float*)(lds + ATT_OFF_W) + wid * 64; LAS float* li_l = wsl; LAS float* al_l = wsl + 32;
    float m_reg = -1e30f, l_reg = 0; f32x16 o[4] = {}; bf16x8 qr[8];
    const int pos = i0 + wid * 32 + r32;
    const bf16_t* Qw = QB + ((long)b * SEQ + pos) * QW + h * 192 + hi * 8;
    LAS bf16x8* qrl = (LAS bf16x8*)(lds + ATT_OFF_Q) + wid * 256 + lane;
#pragma unroll
    for (int d0 = 0; d0 < 8; ++d0) qr[d0] = *(const bf16x8*)(Qw + d0 * 16);
#pragma unroll
    for (int a = 0; a < 2; ++a) {
        const bf16x8 x1 = *(const bf16x8*)(Qw + (8 + a) * 16), x2 = *(const bf16x8*)(Qw + (10 + a) * 16);
        const float* cp = cs + pos * 32 + 16 * a + 8 * hi; const float* sp = sn + pos * 32 + 16 * a + 8 * hi;
        float o1[8], o2[8];
#pragma unroll
        for (int j = 0; j < 8; ++j) { const float c = cp[j], s = sp[j], f1 = bf2f(x1[j]), f2 = bf2f(x2[j]); o1[j] = f1 * c - f2 * s; o2[j] = f1 * s + f2 * c; }
        qrl[a * 64] = pack8(o1); qrl[(2 + a) * 64] = pack8(o2);
    }
    const bf16_t* Kh = KVb + (long)b * SEQ * KVW + h * 256; const bf16_t* Vh = Kh + 128; const bf16_t* Rh = KRb + (long)b * SEQ * 64;
    const int sr = tid >> 4, sc = (tid & 15) * 8, vst0 = v_st(sr, sc), vst1 = v_st(32 + sr, sc);
    const int rr = tid >> 3, rc = (tid & 7) * 8;
    const int vb0 = (int)(uintptr_t)V_lds + v_rd_base(lane);
    bf16x8 vs0, vs1, ks0, ks1, rs0;
    const unsigned so0 = (unsigned)(sr * KVW + sc) * 2u, so1 = so0 + 32u * KVW * 2u, sor = (unsigned)(rr * 64 + rc) * 2u;
#define SLOAD(k0) do { const char* _vb = (const char*)(Vh + (long)(k0) * KVW); const char* _rb = (const char*)(Rh + (long)(k0) * 64); \
    vs0 = *(const bf16x8*)(_vb + so0); vs1 = *(const bf16x8*)(_vb + so1); \
    ks0 = *(const bf16x8*)(_vb + so0 - 256); ks1 = *(const bf16x8*)(_vb + so1 - 256); \
    rs0 = *(const bf16x8*)(_rb + sor); } while (0)
#define SWRITE(bi) do { *(LAS bf16x8*)(V_lds + (bi) * ATT_SHM_V + vst0) = vs0; *(LAS bf16x8*)(V_lds + (bi) * ATT_SHM_V + vst1) = vs1; const int kc = sc * 2; \
    *(LAS bf16x8*)(K_lds + (bi) * ATT_SHM_K + KSWZ(sr, kc)) = ks0; *(LAS bf16x8*)(K_lds + (bi) * ATT_SHM_K + KSWZ(32 + sr, kc)) = ks1; \
    *(LAS bf16x8*)(R_lds + (bi) * ATT_SHM_R + RSWZ(rr, rc * 2)) = rs0; } while (0)
#define RESC(a) do { if (__any((a) < 1.f)) { if (hi == 0) al_l[r32] = (a); asm volatile("s_waitcnt lgkmcnt(0)" ::: "memory"); \
    _Pragma("unroll") for (int d = 0; d < 4; ++d) _Pragma("unroll") for (int r = 0; r < 16; ++r) o[d][r] *= al_l[crow(r, hi)]; } } while (0)
    f32x16 pA0, pA1, pB0, pB1; float mnA, mnB, alA, alB; bf16x8 pa0, pa1, pa2, pa3; constexpr int NT = SEQ / 64;
    SLOAD(0); SWRITE(0); __syncthreads();
    qkt(pA0, pA1, K_lds, R_lds, qr, qrl, r32, hi); partialSM(pA0, pA1, m_reg, mnA, alA);
    SLOAD(64); SWRITE(1); __syncthreads();
    for (int j = 1; j + 1 < NT; j += 2) {
        SBAR(); qkt(pB0, pB1, K_lds + ATT_SHM_K, R_lds + ATT_SHM_R, qr, qrl, r32, hi);
        finishSM(pA0, pA1, alA, l_reg, pa0, pa1, pa2, pa3); SBAR();
        SLOAD((j + 1) * 64); SBAR();
        pv_d0(o, vb0, pa0, pa1, pa2, pa3); partialSM(pB0, pB1, m_reg, mnB, alB);
        __syncthreads(); SWRITE(0);
        RESC(alB); __syncthreads();
        SBAR(); qkt(pA0, pA1, K_lds, R_lds, qr, qrl, r32, hi);
        finishSM(pB0, pB1, alB, l_reg, pa0, pa1, pa2, pa3); SBAR();
        SLOAD((j + 2) * 64); SBAR();
        pv_d0(o, vb0 + ATT_SHM_V, pa0, pa1, pa2, pa3); partialSM(pA0, pA1, m_reg, mnA, alA);
        __syncthreads(); SWRITE(1);
        RESC(alA); __syncthreads();
    }
    SBAR(); qkt(pB0, pB1, K_lds + ATT_SHM_K, R_lds + ATT_SHM_R, qr, qrl, r32, hi);
    finishSM(pA0, pA1, alA, l_reg, pa0, pa1, pa2, pa3); SBAR();
    pv_d0(o, vb0, pa0, pa1, pa2, pa3); partialSM(pB0, pB1, m_reg, mnB, alB);
    __syncthreads(); RESC(alB);
    finishSM(pB0, pB1, alB, l_reg, pa0, pa1, pa2, pa3); SBAR();
    pv_d0(o, vb0 + ATT_SHM_V, pa0, pa1, pa2, pa3);
    if (hi == 0) li_l[r32] = l_reg; asm volatile("s_waitcnt lgkmcnt(0)" ::: "memory");
    float rli[16];
#pragma unroll
    for (int r = 0; r < 16; ++r) rli[r] = __builtin_amdgcn_rcpf(li_l[crow(r, hi)]);
    bf16_t* Ow = OA + ((long)b * SEQ + i0 + wid * 32) * 512 + h * 128;
#pragma unroll
    for (int r = 0; r < 16; ++r) { const int orow = crow(r, hi);
#pragma unroll
        for (int d0 = 0; d0 < 4; ++d0) { const float v = o[d0][r] * rli[r]; Ow[(long)orow * 512 + d0 * 32 + r32] = (bf16_t)(cvtpk(v, v) & 0xffffu); } }
#undef SLOAD
#undef SWRITE
#undef RESC
}

constexpr int HG_LD = 80;
constexpr int HG_TILE = 64 * HG_LD * 2;
constexpr int HG_QD = 0, HG_KI = HG_TILE, HG_KET = 2 * HG_TILE, HG_VT = 3 * HG_TILE, HG_PP = 4 * HG_TILE, HG_ST = 5 * HG_TILE, HG_TOT = 6 * HG_TILE, HG_DEC = HG_TOT + 8 * 64 * 4, HG_RAW = ((HG_DEC + 512 + 1023) / 1024) * 1024, HG_LDS = HG_RAW + 3 * 8192;

DI void hgrn_item(const Params& p, int item, LAS char* lds) {
    const int tid = opaque_tid(), lane = tid & 63, wid = tid >> 6, fr = lane & 15, fq = lane >> 4;
    const int dir = item & 1, h = (item >> 1) & 7, b = item >> 4;
    const bf16_t* proj = (const bf16_t*)(p.ws + WS_PROJ) + (long)b * SEQ * DINP;
    bf16_t* O = (bf16_t*)p.out + (long)dir * MTOK * 512 + (long)b * SEQ * 512 + h * 64;
    const int i = lane, dc = wid * 8;
    const int li = tid >> 3, lch = tid & 7;
    const int colq = C_HQ + h * 64 + lch * 8, colv = C_HI + h * 64 + lch * 8, colf = C_HF + dir * 512 + h * 64 + lch * 8;
    LAS char* RAW = lds + HG_RAW;
    const int raw_wr = li * 128 + ((lch ^ ((li >> 1) & 7)) << 4), raw_rd = i * 128 + ((wid ^ ((i >> 1) & 7)) << 4);
    LAS bf16_t* QD = (LAS bf16_t*)(lds + HG_QD); LAS bf16_t* KI = (LAS bf16_t*)(lds + HG_KI); LAS bf16_t* KET = (LAS bf16_t*)(lds + HG_KET);
    LAS bf16_t* VT = (LAS bf16_t*)(lds + HG_VT); LAS bf16_t* PP = (LAS bf16_t*)(lds + HG_PP); LAS bf16_t* ST = (LAS bf16_t*)(lds + HG_ST);
    LAS float* DEC = (LAS float*)(lds + HG_DEC);
    const int tm = wid >> 1, tn0 = (wid & 1) * 2;
    f32x4 S[2] = {};
    __syncthreads();
#pragma unroll
    for (int t = 0; t < 2; ++t) *(LAS u32x2*)(ST + (16 * (tn0 + t) + fr) * HG_LD + 16 * tm + 4 * fq) = (u32x2){0u, 0u};
    bf16x8 rq, rf, rv;
    { const int c = dir ? 63 : 0; const long row = (long)c * 64 + (dir ? 63 - li : li); const bf16_t* pr = proj + row * DINP;
      rq = *(const bf16x8*)(pr + colq); rf = *(const bf16x8*)(pr + colf); rv = *(const bf16x8*)(pr + colv); }
    for (int n = 0; n < 64; ++n) {
        const int c = dir ? 63 - n : n;
        bf16x8 nq = rq, nf = rf, nv = rv;
        if (n + 1 < 64) { const int c2 = dir ? c - 1 : c + 1; const long row = (long)c2 * 64 + (dir ? 63 - li : li); const bf16_t* pr = proj + row * DINP;
            nq = *(const bf16x8*)(pr + colq); nf = *(const bf16x8*)(pr + colf); nv = *(const bf16x8*)(pr + colv); }
        *(LAS bf16x8*)(RAW + raw_wr) = rq; *(LAS bf16x8*)(RAW + 8192 + raw_wr) = rf; *(LAS bf16x8*)(RAW + 16384 + raw_wr) = rv;
        __syncthreads();
        const bf16x8 xq = *(const LAS bf16x8*)(RAW + raw_rd), xf = *(const LAS bf16x8*)(RAW + 8192 + raw_rd), xv = *(const LAS bf16x8*)(RAW + 16384 + raw_rd);
        float P[8], kk[8];
#pragma unroll
        for (int j = 0; j < 8; ++j) { kk[j] = bf2f(xf[j]); P[j] = 1.f - kk[j]; }
#define DPP_MUL(CTRL, RMASK) _Pragma("unroll") for (int j = 0; j < 8; ++j) { \
            const float t = __builtin_bit_cast(float, __builtin_amdgcn_update_dpp(0x3f800000, __builtin_bit_cast(int, P[j]), CTRL, RMASK, 0xF, false)); P[j] *= t; }
        DPP_MUL(0x111, 0xF) DPP_MUL(0x112, 0xF) DPP_MUL(0x114, 0xF) DPP_MUL(0x118, 0xF) DPP_MUL(0x142, 0xA) DPP_MUL(0x143, 0xC)
#undef DPP_MUL
        float qd[8], ki[8];
#pragma unroll
        for (int j = 0; j < 8; ++j) { const float plast = __builtin_bit_cast(float, __builtin_amdgcn_readlane(__builtin_bit_cast(int, P[j]), 63)); const float sq = bf2f(xq[j]);
            const float rp = __builtin_amdgcn_rcpf(P[j]);
            qd[j] = sq * P[j]; ki[j] = kk[j] * rp; const float ke = ki[j] * plast;
            KET[(dc + j) * HG_LD + i] = (bf16_t)(cvtpk(ke, ke) & 0xffffu); VT[(dc + j) * HG_LD + i] = (bf16_t)xv[j];
            if (lane == 0) DEC[(n & 1) * 64 + dc + j] = plast; }
        *(LAS bf16x8*)(QD + i * HG_LD + dc) = pack8(qd); *(LAS bf16x8*)(KI + i * HG_LD + dc) = pack8(ki);
        __syncthreads();
        bf16x8 QDf[2], KETf[2], KIf[2][2], VTf[2][2], STf[2][2];
#pragma unroll
        for (int ks = 0; ks < 2; ++ks) {
            QDf[ks] = *(const LAS bf16x8*)(QD + (16 * tm + fr) * HG_LD + 32 * ks + 8 * fq);
            KETf[ks] = *(const LAS bf16x8*)(KET + (16 * tm + fr) * HG_LD + 32 * ks + 8 * fq);
#pragma unroll
            for (int t = 0; t < 2; ++t) { const int rw = (16 * (tn0 + t) + fr) * HG_LD + 32 * ks + 8 * fq;
                KIf[t][ks] = *(const LAS bf16x8*)(KI + rw); VTf[t][ks] = *(const LAS bf16x8*)(VT + rw); STf[t][ks] = *(const LAS bf16x8*)(ST + rw); } }
        f32x4 sc[2] = {}, u[2] = {}, oT[2] = {};
#pragma unroll
        for (int t = 0; t < 2; ++t)
#pragma unroll
            for (int ks = 0; ks < 2; ++ks) {
                sc[t] = __builtin_amdgcn_mfma_f32_16x16x32_bf16(KIf[t][ks], QDf[ks], sc[t], 0, 0, 0);
                u[t]  = __builtin_amdgcn_mfma_f32_16x16x32_bf16(KETf[ks], VTf[t][ks], u[t], 0, 0, 0);
                oT[t] = __builtin_amdgcn_mfma_f32_16x16x32_bf16(STf[t][ks], QDf[ks], oT[t], 0, 0, 0);
            }
#pragma unroll
        for (int t = 0; t < 2; ++t) { const int ii = 16 * tm + fr, j0 = 16 * (tn0 + t) + 4 * fq;
            float m[4];
#pragma unroll
            for (int r = 0; r < 4; ++r) m[r] = (j0 + r <= ii) ? sc[t][r] : 0.f;
            *(LAS u32x2*)(PP + ii * HG_LD + j0) = (u32x2){cvtpk(m[0], m[1]), cvtpk(m[2], m[3])}; }
        __syncthreads();
        bf16x8 PPf[2];
#pragma unroll
        for (int ks = 0; ks < 2; ++ks) PPf[ks] = *(const LAS bf16x8*)(PP + (16 * tm + fr) * HG_LD + 32 * ks + 8 * fq);
#pragma unroll
        for (int t = 0; t < 2; ++t)
#pragma unroll
            for (int ks = 0; ks < 2; ++ks) oT[t] = __builtin_amdgcn_mfma_f32_16x16x32_bf16(VTf[t][ks], PPf[ks], oT[t], 0, 0, 0);
        { const long orow = (long)c * 64 + (dir ? 63 - (16 * tm + fr) : (16 * tm + fr));
#pragma unroll
          for (int t = 0; t < 2; ++t) *(u32x2*)(O + orow * 512 + 16 * (tn0 + t) + 4 * fq) = (u32x2){cvtpk(oT[t][0], oT[t][1]), cvtpk(oT[t][2], oT[t][3])}; }
        const f32x4 dcy = *(const LAS f32x4*)(DEC + (n & 1) * 64 + 16 * tm + 4 * fq);
#pragma unroll
        for (int t = 0; t < 2; ++t) { S[t] = dcy * S[t] + u[t];
            *(LAS u32x2*)(ST + (16 * (tn0 + t) + fr) * HG_LD + 16 * tm + 4 * fq) = (u32x2){cvtpk(S[t][0], S[t][1]), cvtpk(S[t][2], S[t][3])}; }
        rq = nq; rf = nf; rv = nv;
    }
}

DI void hgrn_item_naive(const Params& p, int item, LAS char* lds) {
    const int tid = threadIdx.x; const int d = tid >> 3, e0 = (tid & 7) * 8;
    const int dir = item & 1, h = (item >> 1) & 7, b = item >> 4;
    const bf16_t* proj = (const bf16_t*)(p.ws + WS_PROJ) + (long)b * SEQ * DINP;
    bf16_t* O = (bf16_t*)p.out + (long)dir * MTOK * 512 + (long)b * SEQ * 512 + h * 64;
    const float a0 = p.lb_logits[dir * 1024 + h * 64 + d], a1 = p.lb_logits[dir * 1024 + 512 + h * 64 + d];
    const float lb = 1.f / (1.f + expf(a1 - a0));
    float S[8] = {0, 0, 0, 0, 0, 0, 0, 0};
    LAS float* part = (LAS float*)lds;
    __syncthreads();
    for (int n = 0; n < SEQ; ++n) {
        const int t = dir ? SEQ - 1 - n : n;
        const bf16_t* pr = proj + (long)t * DINP;
        const float z = bf2f((short)pr[C_HF + dir * 512 + h * 64 + d]); const float sig = 1.f / (1.f + expf(-z));
        const float f = lb + (1.f - lb) * sig; const float k = (1.f - lb) * (1.f / (1.f + expf(z)));
        float q = bf2f((short)pr[C_HQ + h * 64 + d]); q = q / (1.f + expf(-q));
        const bf16x8 vv = *(const bf16x8*)(pr + C_HI + h * 64 + e0);
#pragma unroll
        for (int j = 0; j < 8; ++j) { const float v = bf2f(vv[j]); S[j] = f * S[j] + k * v; part[d * 64 + e0 + j] = S[j] * q; }
        __syncthreads();
        if (tid < 64) { float o = 0.f;
#pragma unroll 8
            for (int dd = 0; dd < 64; ++dd) o += part[dd * 64 + tid];
            O[(long)t * 512 + tid] = (bf16_t)(cvtpk(o, o) & 0xffffu); }
        __syncthreads();
    }
}

DI void dbg_hgrn(const Params& p, LAS char* lds, int dir, unsigned* flag, unsigned bit) {
    const int tid = threadIdx.x; const int d = tid >> 3, e0 = (tid & 7) * 8;
    const int b = 1, h = 3;
    const bf16_t* proj = (const bf16_t*)(p.ws + WS_PROJ) + (long)b * SEQ * DINP;
    const bf16_t* O = (const bf16_t*)p.out + (long)dir * MTOK * 512 + (long)b * SEQ * 512 + h * 64;
    const float a0 = p.lb_logits[dir * 1024 + h * 64 + d], a1 = p.lb_logits[dir * 1024 + 512 + h * 64 + d];
    const float lb = 1.f / (1.f + expf(a1 - a0));
    float S[8] = {0, 0, 0, 0, 0, 0, 0, 0};
    LAS float* part = (LAS float*)lds;
    float maxdiff = 0.f, maxref = 0.f;
    __syncthreads();
    for (int n = 0; n < 512; ++n) {
        const int t = dir ? SEQ - 1 - n : n;
        const bf16_t* pr = proj + (long)t * DINP;
        const float z = bf2f((short)pr[C_HF + dir * 512 + h * 64 + d]); const float sig = 1.f / (1.f + expf(-z));
        const float f = lb + (1.f - lb) * sig; const float k = (1.f - lb) * (1.f / (1.f + expf(z)));
        float q = bf2f((short)pr[C_HQ + h * 64 + d]); q = q / (1.f + expf(-q));
#pragma unroll
        for (int j = 0; j < 8; ++j) { const float v = bf2f((short)pr[C_HI + h * 64 + e0 + j]); S[j] = f * S[j] + k * v; part[d * 64 + e0 + j] = S[j] * q; }
        __syncthreads();
        if (tid < 64) { float o = 0.f; for (int dd = 0; dd < 64; ++dd) o += part[dd * 64 + tid]; const float fast = bf2f((short)O[(long)t * 512 + tid]);
            maxdiff = fmaxf(maxdiff, fabsf(o - fast)); maxref = fmaxf(maxref, fabsf(o)); }
        __syncthreads();
    }
    if (tid < 64) {
#pragma unroll
        for (int o = 32; o > 0; o >>= 1) { maxdiff = fmaxf(maxdiff, __shfl_xor(maxdiff, o)); maxref = fmaxf(maxref, __shfl_xor(maxref, o)); }
        if (tid == 0 && !(maxdiff <= 0.03f * maxref)) atomicOr(flag, bit);
    }
    __syncthreads();
}
DI void dbg_attn(const Params& p, LAS char* lds, unsigned* flag, unsigned bit) {
    const int tid = threadIdx.x, row = tid >> 3, e0 = (tid & 7) * 16;
    const int b = 2, h = 1, r0 = 1000;
    const bf16_t* QB = (const bf16_t*)(p.ws + WS_QB); const bf16_t* KV = (const bf16_t*)(p.ws + WS_KV); const bf16_t* KR = (const bf16_t*)(p.ws + WS_KR);
    const bf16_t* OA = (const bf16_t*)(p.ws + WS_OA); const float* cs = (const float*)(p.ws + WS_COS); const float* sn = (const float*)(p.ws + WS_SIN);
    LAS float* qs = (LAS float*)lds;
    __syncthreads();
    for (int idx = tid; idx < 64 * 192; idx += 512) { const int rw = idx / 192, dd = idx % 192, pos = r0 + rw; const bf16_t* qp = QB + ((long)b * SEQ + pos) * QW + h * 192;
        float val = bf2f((short)qp[dd]);
        if (dd >= 128) { const int i = (dd - 128) & 31; const float x1 = bf2f((short)qp[128 + i]), x2 = bf2f((short)qp[160 + i]), c = cs[pos * 32 + i], s = sn[pos * 32 + i];
            val = (dd - 128 < 32) ? x1 * c - x2 * s : x1 * s + x2 * c; }
        qs[idx] = val; }
    __syncthreads();
    float m = -1e30f, l = 0.f, o[16];
#pragma unroll
    for (int j = 0; j < 16; ++j) o[j] = 0.f;
    for (int key = 0; key < SEQ; ++key) {
        const bf16_t* Kp = KV + ((long)b * SEQ + key) * KVW + h * 256; const bf16_t* Rp = KR + ((long)b * SEQ + key) * 64;
        float s = 0.f;
        for (int dd = 0; dd < 128; ++dd) s += qs[row * 192 + dd] * bf2f((short)Kp[dd]);
        for (int dd = 0; dd < 64; ++dd) s += qs[row * 192 + 128 + dd] * bf2f((short)Rp[dd]);
        s *= ATT_SCALE;
        const float mn = fmaxf(m, s), alpha = expf(m - mn), pe = expf(s - mn); l = l * alpha + pe; m = mn;
#pragma unroll
        for (int j = 0; j < 16; ++j) o[j] = o[j] * alpha + pe * bf2f((short)Kp[128 + e0 + j]);
    }
    float maxdiff = 0.f, maxref = 0.f;
#pragma unroll
    for (int j = 0; j < 16; ++j) { const float ref = o[j] / l, fast = bf2f((short)OA[((long)b * SEQ + r0 + row) * 512 + h * 128 + e0 + j]);
        maxdiff = fmaxf(maxdiff, fabsf(ref - fast)); maxref = fmaxf(maxref, fabsf(ref)); }
#pragma unroll
    for (int of = 32; of > 0; of >>= 1) { maxdiff = fmaxf(maxdiff, __shfl_xor(maxdiff, of)); maxref = fmaxf(maxref, __shfl_xor(maxref, of)); }
    if ((tid & 63) == 0 && !(maxdiff <= 0.03f * maxref)) atomicOr(flag, bit);
    __syncthreads();
}


#define XB_TMO      128
#define XB_XCNT(j)  (256  + 64 * (j))
#define XB_XSUB(j)  (1280 + 64 * (j))
#define XB_XGEN(j)  (2304 + 64 * (j))
#define XB_TOP      3328
#define XB_TOPGEN   3392
#define XCD_BAR_WORDS 3456
#define XB_SPIN_CAP (1u << 20)
DI unsigned xb_ld(unsigned* p)              { return __hip_atomic_load(p, __ATOMIC_RELAXED, __HIP_MEMORY_SCOPE_AGENT); }
DI unsigned xb_add(unsigned* p, unsigned v) { return __hip_atomic_fetch_add(p, v, __ATOMIC_RELAXED, __HIP_MEMORY_SCOPE_AGENT); }
DI unsigned xb_xcc_id() { return (unsigned)__builtin_amdgcn_s_getreg((3 << 11) | 20) & 0xFu; }
#define XB_SPIN(cond, bar) do { unsigned _sp = 0; while (cond) { __builtin_amdgcn_s_sleep(1); \
    if ((++_sp & 255u) == 0u) { if (xb_ld(&(bar)[XB_TMO])) break; if (_sp > XB_SPIN_CAP) { atomicAdd(&(bar)[XB_TMO], 1u); break; } } } } while (0)
struct XcdBarrier { unsigned* bar; unsigned x; volatile LAS unsigned* st; };
DI XcdBarrier xcd_barrier_post(unsigned* bar, volatile LAS unsigned* st) {
    XcdBarrier b; b.bar = bar; b.x = xb_xcc_id(); b.st = st;
    if (threadIdx.x == 0) (void)xb_add(&bar[XB_XCNT(b.x)], 1u);
    return b;
}
DI void xcd_barrier_complete(unsigned* bar, unsigned x, unsigned& nloc, unsigned& nx) {
    const unsigned G = gridDim.x * gridDim.y * gridDim.z;
    unsigned sum, cnt, mine, sp = 0u;
    for (;;) {
        sum = 0u; cnt = 0u; mine = 0u;
#pragma unroll
        for (unsigned j = 0; j < 16; ++j) { const unsigned c = xb_ld(&bar[XB_XCNT(j)]); sum += c; cnt += (c > 0u) ? 1u : 0u; mine = (j == x) ? c : mine; }
        if (sum == G) break;
        __builtin_amdgcn_s_sleep(1);
        if ((++sp & 255u) == 0u) { if (xb_ld(&bar[XB_TMO])) break; if (sp > XB_SPIN_CAP) { atomicAdd(&bar[XB_TMO], 1u); break; } }
    }
    nloc = mine > 0u ? mine : 1u; nx = cnt > 0u ? cnt : 1u;
}
DI void xcd_barrier(const XcdBarrier& b) {
    asm volatile("s_waitcnt vmcnt(0)" ::: "memory");
    __syncthreads();
    if (threadIdx.x == 0) {
        unsigned* bar = b.bar;
        __builtin_amdgcn_s_waitcnt(0);
        unsigned nloc = b.st[0], nx = b.st[1];
        if (nloc == 0u) { xcd_barrier_complete(bar, b.x, nloc, nx); b.st[0] = nloc; b.st[1] = nx; }
        const unsigned old = xb_add(&bar[XB_XSUB(b.x)], 1u);
        const unsigned gen = old / nloc;
        if (old + 1u == (gen + 1u) * nloc) {
            __builtin_amdgcn_fence(__ATOMIC_RELEASE, "agent");
            asm volatile("s_waitcnt vmcnt(0)" ::: "memory");
            const unsigned og = xb_add(&bar[XB_TOP], 1u);
            const unsigned tg = og / nx;
            if (og + 1u == (tg + 1u) * nx) xb_add(&bar[XB_TOPGEN], 1u);
            else XB_SPIN(xb_ld(&bar[XB_TOPGEN]) == tg, bar);
            __builtin_amdgcn_fence(__ATOMIC_ACQUIRE, "agent");
            xb_add(&bar[XB_XGEN(b.x)], 1u);
            asm volatile("s_waitcnt vmcnt(0)" ::: "memory");
        } else {
            XB_SPIN(xb_ld(&bar[XB_XGEN(b.x)]) == gen, bar);
            __builtin_amdgcn_fence(__ATOMIC_ACQUIRE, "agent");
            asm volatile("s_waitcnt vmcnt(0)" ::: "memory");
        }
    }
    __syncthreads();
}
constexpr size_t WS_BAR = WS_END;
static_assert(WS_BAR + XCD_BAR_WORDS * 4 <= (size_t)1 << 30, "barrier words");

constexpr int LDS_BYTES = GEMM_LDS + 256 + 2048;
static_assert(ATT_LDS <= LDS_BYTES && HG_LDS <= LDS_BYTES, "LDS");

__global__ void __launch_bounds__(512) mega_fwd(Params p) {
    extern __shared__ __attribute__((aligned(16))) char dyn_lds[];
    LAS char* lds = (LAS char*)dyn_lds;
    cg::grid_group grid = cg::this_grid();
    unsigned char* ws = p.ws;
    const int nw = gridDim.x * 8;
    volatile LAS unsigned* xst = (volatile LAS unsigned*)(lds + GEMM_LDS);
    if (threadIdx.x == 0) { xst[0] = 0u; xst[1] = 0u; }
    __syncthreads();
    const XcdBarrier xb = xcd_barrier_post((unsigned*)(ws + WS_BAR), xst);
#ifndef PHASE_MASK
#define PHASE_MASK 0xFFFF
#endif
#define PH(k) if constexpr ((PHASE_MASK >> (k)) & 1)
    unsigned* dbgflag = (unsigned*)(ws + WS_END);
    if (blockIdx.x == 0 && threadIdx.x == 0) *dbgflag = 0u;
    PH(0) phase0(p, fresh_gw(), nw);
    if (p.ws == nullptr) grid.sync();
    xcd_barrier(xb);
    PH(1) gemm_phase((const bf16_t*)(ws + WS_H), DM, (const bf16_t*)(ws + WS_WIN), DM, MTOK / BM, DINP / BM, EpiProj{(bf16_t*)(ws + WS_PROJ), (float*)(ws + WS_SSQQ), (float*)(ws + WS_SSQKV), (const float*)(ws + WS_OML), (const float*)(ws + WS_SSQ0)}, lds);
    xcd_barrier(xb);
    PH(2) phase_krope(p, fresh_gw(), nw);
    PH(11) for (int it = blockIdx.x; it < NBATCH * 8 * 2; it += gridDim.x) hgrn_item(p, it, lds);
    __syncthreads();
    PH(3) {
    gemm_phase((const bf16_t*)(ws + WS_PROJ) + C_CQ, DINP, (const bf16_t*)(ws + WS_WQB), QLORA, MTOK / BM, QW / BM, EpiBf16Scale{(bf16_t*)(ws + WS_QB), QW, (const float*)(ws + WS_SSQQ), 1.f / QLORA}, lds);
    gemm_phase((const bf16_t*)(ws + WS_PROJ) + C_CKV, DINP, (const bf16_t*)(ws + WS_WKVB), KVLORA, MTOK / BM, KVW / BM, EpiBf16Scale{(bf16_t*)(ws + WS_KV), KVW, (const float*)(ws + WS_SSQKV), 1.f / KVLORA}, lds);
    }
    xcd_barrier(xb);
    PH(4) for (int u = blockIdx.x; u < NBATCH * 4 * (SEQ / 256); u += gridDim.x) {
        const int cbk = (int)blockIdx.x, rnd = u / (int)gridDim.x, xcd = cbk & 7, idx = cbk >> 3;
        const int pair = (gridDim.x == 256) ? rnd * 16 + xcd * 2 + (idx >> 4) : (u >> 4), qb = (gridDim.x == 256) ? (idx & 15) : (u & 15), h = pair & 3, b = pair >> 2;
        __syncthreads();
        attn_unit((const bf16_t*)(ws + WS_QB), (const bf16_t*)(ws + WS_KV), (const bf16_t*)(ws + WS_KR), (const float*)(ws + WS_COS), (const float*)(ws + WS_SIN),
                  (bf16_t*)(ws + WS_OA), b, h, qb * 256, lds);
    }
    xcd_barrier(xb);
    PH(5) phase_mix_pre(p, fresh_gw(), nw);
    xcd_barrier(xb);
    PH(6) gemm_phase((const bf16_t*)p.out + (long)MTOK * 1024, DM, (const bf16_t*)(ws + WS_WOUT), DM, MTOK / BM, DM / BM, EpiResid<false>{(const void*)(ws + WS_H), (bf16_t*)(ws + WS_X1), (float*)(ws + WS_SSQ1)}, lds);
    xcd_barrier(xb);
    PH(8) gemm_phase((const bf16_t*)(ws + WS_X1), DM, (const bf16_t*)(ws + WS_WGU), DM, MTOK / BM, 2 * DFF / BM, EpiSwiGLU{(bf16_t*)(ws + WS_HID), (const float*)(ws + WS_SSQ1)}, lds);
    xcd_barrier(xb);
    PH(9) { if (threadIdx.x < 256) ((LAS float*)(lds + GEMM_LDS + 256))[threadIdx.x] = 0.f; __syncthreads();
            gemm_phase((const bf16_t*)(ws + WS_HID), DFF, (const bf16_t*)(ws + WS_WDN), DFF, MTOK / BM, DM / BM, EpiFinal{(const bf16_t*)(ws + WS_X1), p.out, (float*)(ws + WS_XST), p.final_norm_g, lds}, lds); }
}

extern "C" void kernel_launch(void* const* d_in, const int* in_sizes, int n_in, void* d_out, int out_size, void* d_ws, size_t ws_size, hipStream_t stream) {
    static int grid_blocks = 0;
    if (grid_blocks == 0) {
        if (n_in != 16 || in_sizes[0] != MTOK * DM || out_size != MTOK * DM || ws_size < WS_TOTAL) { fprintf(stderr, "kernel_launch: shape mismatch (n_in %d, ws %zu)\n", n_in, ws_size); grid_blocks = -1; return; }
        int dev = 0, cus = 0, per_cu = 0;
        hipGetDevice(&dev); hipDeviceGetAttribute(&cus, hipDeviceAttributeMultiprocessorCount, dev);
        if (hipFuncSetAttribute((const void*)mega_fwd, hipFuncAttributeMaxDynamicSharedMemorySize, LDS_BYTES) != hipSuccess) { fprintf(stderr, "hipFuncSetAttribute failed\n"); grid_blocks = -1; return; }
        if (hipOccupancyMaxActiveBlocksPerMultiprocessor(&per_cu, (const void*)mega_fwd, 512, LDS_BYTES) != hipSuccess || per_cu < 1) { fprintf(stderr, "occupancy query: %d\n", per_cu); per_cu = 1; }
        (void)hipGetLastError();
        grid_blocks = cus < 256 ? cus : 256;
    }
    if (grid_blocks < 0) return;
    Params p{};
    p.x = (const float*)d_in[0]; p.norm1_g = (const float*)d_in[1]; p.w_in = (const float*)d_in[2]; p.lb_logits = (const float*)d_in[3]; p.hgrn_norm_g = (const float*)d_in[4];
    p.q_a_norm_g = (const float*)d_in[5]; p.w_q_b = (const float*)d_in[6]; p.kv_a_norm_g = (const float*)d_in[7]; p.w_kv_b = (const float*)d_in[8]; p.mla_norm_g = (const float*)d_in[9];
    p.w_out = (const float*)d_in[10]; p.norm2_g = (const float*)d_in[11]; p.w_gate = (const float*)d_in[12]; p.w_up = (const float*)d_in[13]; p.w_down = (const float*)d_in[14]; p.final_norm_g = (const float*)d_in[15];
    p.out = (float*)d_out; p.ws = (unsigned char*)d_ws;
    if (hipMemsetAsync((char*)d_ws + WS_BAR, 0, XCD_BAR_WORDS * 4, stream) != hipSuccess) { fprintf(stderr, "memset of barrier words failed\n"); return; }
    void* args[] = {&p};
    hipError_t e = hipLaunchCooperativeKernel((const void*)mega_fwd, dim3(grid_blocks), dim3(512), args, LDS_BYTES, stream);
    if (e != hipSuccess) fprintf(stderr, "cooperative launch failed: %s (grid %d)\n", hipGetErrorString(e), grid_blocks);
}
```
